# Optimizing an MI355X kernel written in HIP

```python
import jax, jax.numpy as jnp
from jax import lax
import numpy as np

D_MODEL = 1024
BATCH = 4
SEQ = 8192
DEPTH = 2

CHUNK = 64
Q_BLOCK = 128
HEAD_DIM = 64
ATTN_HEADS = D_MODEL // 128
CONV_GROUPS = D_MODEL // 256
HGRN_HEADS = D_MODEL // 256
CONV_WIDTH = 3
ATTN_W = ATTN_HEADS * HEAD_DIM
CONV_C = CONV_GROUPS * HEAD_DIM
HGRN_W = HGRN_HEADS * HEAD_DIM
D_MIX = ATTN_W + CONV_C + HGRN_W
IN_SIZES = (ATTN_W, ATTN_W, ATTN_W, ATTN_HEADS,
            CONV_C, CONV_C, CONV_C,
            HGRN_W, HGRN_W, HGRN_W, HGRN_W)
D_IN = sum(IN_SIZES)
IN_SPLITS = [int(v) for v in np.cumsum(IN_SIZES)[:-1]]
D_FF = (7 * D_MODEL) // 2
N_EXPERTS = 8
TOP_K = 2
N_DENSE = (DEPTH + 1) // 2
N_MOE = DEPTH // 2
EPS = 1e-6
FORGET_BIAS_MEAN = 3.0
MASK_VALUE = -1e30
MASK_LOG_DECAY = -1e4
TINY = 1e-30

kernel_name = "hybrid_fox_shortconv_hgrn2_moe"


def rms(x):
    xf = x.astype(jnp.float32)
    return xf * lax.rsqrt(jnp.mean(xf * xf, axis=-1, keepdims=True) + EPS)


def rms_norm(x, g):
    return (rms(x) * g.astype(jnp.float32)).astype(x.dtype)


def swiglu(x, w_gate, w_up, w_down):
    return (jax.nn.silu(x @ w_gate) * (x @ w_up)) @ w_down


def forgetting_attention(q, k, v, f_logit, g_q, g_k):
    B, S, H, Dh = q.shape
    q = rms(q) * g_q.astype(jnp.float32)
    k = rms(k) * g_k.astype(jnp.float32)
    v = v.astype(jnp.float32)
    dcum = jnp.cumsum(jax.nn.log_sigmoid(f_logit.astype(jnp.float32)), axis=1)
    scale = np.float32(1.0 / np.sqrt(Dh))
    nb = S // Q_BLOCK
    q_blocks = q.reshape(B, nb, Q_BLOCK, H, Dh).transpose(1, 0, 3, 2, 4)
    d_blocks = dcum.reshape(B, nb, Q_BLOCK, H).transpose(1, 0, 3, 2)
    k_t = k.transpose(0, 2, 1, 3)
    v_t = v.transpose(0, 2, 1, 3)
    d_k = dcum.transpose(0, 2, 1)
    k_pos = jnp.arange(S)

    def block(args):
        q_i, d_i, i = args
        q_pos = i * Q_BLOCK + jnp.arange(Q_BLOCK)
        logits = (jnp.einsum('bhqd,bhkd->bhqk', q_i, k_t) * scale
                  + d_i[..., None] - d_k[:, :, None, :])
        mask = k_pos[None, :] <= q_pos[:, None]
        p = jax.nn.softmax(jnp.where(mask, logits, MASK_VALUE), axis=-1)
        return jnp.einsum('bhqk,bhkd->bhqd', p, v_t)

    o = lax.map(block, (q_blocks, d_blocks, jnp.arange(nb)))
    return o.transpose(1, 0, 3, 2, 4).reshape(B, S, H * Dh)


def short_conv(x_in, b_gate, c_gate, w):
    S = x_in.shape[1]
    u = (c_gate * x_in).astype(jnp.float32)
    up = jnp.pad(u, ((0, 0), (CONV_WIDTH - 1, 0), (0, 0)))
    wf = w.astype(jnp.float32)
    y = up[:, 0:S] * wf[0]
    for j in range(1, CONV_WIDTH):
        y = y + up[:, j:j + S] * wf[j]
    return b_gate.astype(jnp.float32) * y


def hgrn2(q, f_logit, i_in, lb):
    B, S, H, d = q.shape
    q = jax.nn.silu(q.astype(jnp.float32))
    z = f_logit.astype(jnp.float32)
    lb = lb.reshape(H, d).astype(jnp.float32)
    f = lb + (1.0 - lb) * jax.nn.sigmoid(z)
    log_f = jnp.log(jnp.maximum(f, TINY))
    k = (1.0 - lb) * jax.nn.sigmoid(-z)
    v = i_in.astype(jnp.float32)
    n_chunks = S // CHUNK

    def to_chunks(t):
        return t.reshape(B, n_chunks, CHUNK, H, d).transpose(1, 0, 3, 2, 4)

    causal = jnp.tril(jnp.ones((CHUNK, CHUNK), dtype=bool))

    def step(state, inp):
        q_c, k_c, v_c, l_c = inp
        c = jnp.cumsum(l_c, axis=2)
        o_inter = jnp.einsum('bhtk,bhkv->bhtv', q_c * jnp.exp(c), state)
        diff = c[:, :, :, None, :] - c[:, :, None, :, :]
        decay = jnp.exp(jnp.where(causal[:, :, None], diff, MASK_LOG_DECAY))
        a = jnp.einsum('bhtk,bhsk,bhtsk->bhts', q_c, k_c, decay)
        o = o_inter + jnp.einsum('bhts,bhsv->bhtv', a, v_c)
        c_last = c[:, :, -1:, :]
        k_dec = k_c * jnp.exp(c_last - c)
        state = (jnp.exp(c_last[:, :, 0, :])[..., None] * state
                 + jnp.einsum('bhsk,bhsv->bhkv', k_dec, v_c))
        return state, o

    state0 = jnp.zeros((B, H, d, d), jnp.float32)
    _, o = lax.scan(step, state0, (to_chunks(q), to_chunks(k), to_chunks(v), to_chunks(log_f)))
    return o.transpose(1, 0, 3, 2, 4).reshape(B, S, H * d)


def moe_swiglu(h, w_router, b_router, w_gate, w_up, w_down):
    B, S, D = h.shape
    t = h.reshape(B * S, D)
    logits = (t @ w_router).astype(jnp.float32) + b_router.astype(jnp.float32)
    top_v, top_i = lax.top_k(logits, TOP_K)
    top_w = jax.nn.softmax(top_v, axis=-1)
    gates = jnp.sum(jax.nn.one_hot(top_i, N_EXPERTS, dtype=jnp.float32) * top_w[..., None], axis=1)
    out = jnp.zeros_like(t)
    for e in range(N_EXPERTS):
        out = out + gates[:, e:e + 1].astype(t.dtype) * swiglu(t, w_gate[e], w_up[e], w_down[e])
    return out.reshape(B, S, D)


def setup_inputs(seed: int = 0) -> dict:
    key = jax.random.key(seed)
    ks = jax.random.split(key, 24)
    f32 = jnp.float32
    nrm = lambda k, shape, s: jax.random.normal(k, shape, f32) * s
    return {
        "x": nrm(ks[0], (BATCH, SEQ, D_MODEL), 1.0),
        "norm_mix": 1.0 + nrm(ks[1], (DEPTH, D_MODEL), 0.02),
        "w_in": nrm(ks[2], (DEPTH, D_MODEL, D_IN), D_MODEL ** -0.5),
        "attn_f_bias": FORGET_BIAS_MEAN + nrm(ks[3], (DEPTH, ATTN_HEADS), 0.1),
        "q_norm_gain": 1.0 + nrm(ks[4], (DEPTH, HEAD_DIM), 0.02),
        "k_norm_gain": 1.0 + nrm(ks[5], (DEPTH, HEAD_DIM), 0.02),
        "conv_w": nrm(ks[6], (DEPTH, CONV_WIDTH, CONV_C), CONV_WIDTH ** -0.5),
        "hgrn_lb_logits": nrm(ks[7], (DEPTH, HGRN_W), 0.1),
        "mix_out_gain": 1.0 + nrm(ks[8], (DEPTH, D_MIX), 0.02),
        "w_out": nrm(ks[9], (DEPTH, D_MIX, D_MODEL), D_MIX ** -0.5),
        "norm_ffn": 1.0 + nrm(ks[10], (DEPTH, D_MODEL), 0.02),
        "ffn_w_gate": nrm(ks[11], (N_DENSE, D_MODEL, D_FF), D_MODEL ** -0.5),
        "ffn_w_up": nrm(ks[12], (N_DENSE, D_MODEL, D_FF), D_MODEL ** -0.5),
        "ffn_w_down": nrm(ks[13], (N_DENSE, D_FF, D_MODEL), D_FF ** -0.5),
        "moe_router_w": nrm(ks[14], (N_MOE, D_MODEL, N_EXPERTS), D_MODEL ** -0.5),
        "moe_router_b": nrm(ks[15], (N_MOE, N_EXPERTS), 0.01),
        "moe_w_gate": nrm(ks[16], (N_MOE, N_EXPERTS, D_MODEL, D_FF), D_MODEL ** -0.5),
        "moe_w_up": nrm(ks[17], (N_MOE, N_EXPERTS, D_MODEL, D_FF), D_MODEL ** -0.5),
        "moe_w_down": nrm(ks[18], (N_MOE, N_EXPERTS, D_FF, D_MODEL), D_FF ** -0.5),
    }


def reference(x, norm_mix, w_in, attn_f_bias, q_norm_gain, k_norm_gain, conv_w,
              hgrn_lb_logits, mix_out_gain, w_out, norm_ffn, ffn_w_gate, ffn_w_up,
              ffn_w_down, moe_router_w, moe_router_b, moe_w_gate, moe_w_up, moe_w_down):
    B, S, _ = x.shape
    dt = x.dtype
    p_lb = jax.nn.softmax(hgrn_lb_logits.astype(jnp.float32), axis=0)
    lb_all = jnp.cumsum(p_lb, axis=0) - p_lb[0]
    for l in range(DEPTH):
        h = rms_norm(x, norm_mix[l])
        z = h @ w_in[l]
        (a_q, a_k, a_v, a_f, c_x, c_b, c_c,
         r_q, r_f, r_i, r_g) = jnp.split(z, IN_SPLITS, axis=-1)
        a_f = a_f + attn_f_bias[l].astype(dt)
        y_a = forgetting_attention(a_q.reshape(B, S, ATTN_HEADS, HEAD_DIM),
                                   a_k.reshape(B, S, ATTN_HEADS, HEAD_DIM),
                                   a_v.reshape(B, S, ATTN_HEADS, HEAD_DIM),
                                   a_f, q_norm_gain[l], k_norm_gain[l])
        y_c = short_conv(c_x, c_b, c_c, conv_w[l])
        y_r = hgrn2(r_q.reshape(B, S, HGRN_HEADS, HEAD_DIM),
                    r_f.reshape(B, S, HGRN_HEADS, HEAD_DIM),
                    r_i.reshape(B, S, HGRN_HEADS, HEAD_DIM), lb_all[l])
        y = jnp.concatenate([y_a, y_c, y_r], axis=-1)
        y = rms(y.reshape(B, S, D_MIX // HEAD_DIM, HEAD_DIM)).reshape(B, S, D_MIX)
        y = y * mix_out_gain[l].astype(jnp.float32)
        y = jnp.concatenate([y[..., :ATTN_W + CONV_C],
                             y[..., ATTN_W + CONV_C:] * jax.nn.silu(r_g.astype(jnp.float32))], axis=-1)
        x = x + y.astype(dt) @ w_out[l]
        h = rms_norm(x, norm_ffn[l])
        if l % 2 == 0:
            j = l // 2
            x = x + swiglu(h, ffn_w_gate[j], ffn_w_up[j], ffn_w_down[j])
        else:
            j = l // 2
            x = x + moe_swiglu(h, moe_router_w[j], moe_router_b[j],
                               moe_w_gate[j], moe_w_up[j], moe_w_down[j])
    return x
```

```cpp
#include <hip/hip_runtime.h>
#include <cstdio>
#include <cstdint>
#include <cstddef>
#include <type_traits>
namespace pg8 {
#define PG8_LAS __attribute__((address_space(3)))
typedef unsigned short bf16_t;
typedef short bf16x8 __attribute__((ext_vector_type(8)));
typedef float f32x4 __attribute__((ext_vector_type(4)));
typedef unsigned u32x4 __attribute__((ext_vector_type(4)));
typedef int v4i32 __attribute__((ext_vector_type(4)));
typedef int v8i32 __attribute__((ext_vector_type(8)));

constexpr int BM = 256, BK = 64, HALF = 128, HTB = HALF * BK * 2  , STAGE_BYTES = 8 * HTB, NXCD = 8, WGM = 8;

__host__ __device__ __forceinline__ int lds_byte(int r, int c) { const int st = (r >> 4) * 2 + (c >> 5), rr = r & 15, cc = c & 31, ob = rr * 64 + cc * 2; return st * 1024 + (ob ^ (((ob >> 9) & 1) << 5)); }
__host__ __device__ __forceinline__ void stage_rc(int b, int& R, int& C) { const int st = b / 1024, sb = b % 1024, swz = sb ^ (((sb >> 9) & 1) << 5); R = (st >> 1) * 16 + swz / 64; C = (st & 1) * 32 + (swz % 64) / 2; }
__host__ __device__ __forceinline__ int perm32(int rho) { const int n = rho >> 4, i = rho & 15; return 8 * (i >> 2) + 4 * n + (i & 3); }

__device__ __forceinline__ int pg8_lane_id() { int l; asm volatile("v_mbcnt_lo_u32_b32 %0, -1, 0\n\tv_mbcnt_hi_u32_b32 %0, -1, %0" : "=v"(l)); return l; }
struct Unit { int pm, pn; long boff; int ex; };
struct Gemm { const bf16_t* A; const bf16_t* Bt; int M, N, K; };

struct StaticOrder {
    int nM, nN, nwg, G, c;
    __host__ __device__ void init(int M, int N, int G_, int c_) { nM = M / BM; nN = N / BM; nwg = nM * nN; G = G_; c = c_; }
    __host__ __device__ bool next(int i, Unit& u) const { return at(i * G + c, u); }
    __host__ __device__ bool at(int L, Unit& u) const {
        if (L < 0 || L >= nwg) return false;
        int wgid = L; { const int q = nwg / NXCD, r = nwg % NXCD, xcd = wgid % NXCD, off = wgid / NXCD; wgid = (xcd < r ? xcd * (q + 1) : r * (q + 1) + (xcd - r) * q) + off; }
        const int nig = WGM * nN, gid = wgid / nig, fm = gid * WGM, gsz = (nM - fm) < WGM ? (nM - fm) : WGM;
        u.pm = fm + ((wgid % nig) % gsz); u.pn = (wgid % nig) / gsz; u.boff = 0; u.ex = 0; return true;
    }
    __device__ __forceinline__ void a_ready(const Unit&) const {}
    __device__ __forceinline__ void done(const Unit&) const {}
};

__device__ __forceinline__ unsigned cvt_pk_bf16(float lo, float hi) { unsigned r; asm volatile("v_cvt_pk_bf16_f32 %0, %1, %2" : "=v"(r) : "v"(lo), "v"(hi)); return r; }
__device__ __forceinline__ float silu_f(float v) { return v * __builtin_amdgcn_rcpf(1.0f + __builtin_amdgcn_exp2f(-1.4426950408889634f * v)); }

template <long HGD> struct EpiStoreI8 {
    static constexpr bool PERM = true, AFTER_DRAIN = false;
    bf16_t* O; int ldc; const float* sa; const float* sb; const float* gq; const float* gk;
    struct Pre { f32x4 sbv[2][2]; float sr[2][4]; };
    __device__ __forceinline__ Pre pre(const Unit& u, int wr, int wc, int fr, int fq) const { Pre p;
        const int row0 = u.pm * BM + wr * 64 + fr; const int pcol0 = u.pn * BM + wc * 32 + 8 * fq;
#pragma unroll
        for (int bj = 0; bj < 2; ++bj)
#pragma unroll
            for (int n = 0; n < 2; ++n) p.sbv[bj][n] = *(const f32x4*)(sb + pcol0 + bj * HALF + 4 * n);
#pragma unroll
        for (int ai = 0; ai < 2; ++ai)
#pragma unroll
            for (int m = 0; m < 4; ++m) p.sr[ai][m] = sa[row0 + ai * HALF + m * 16];
        return p; }
    __device__ __forceinline__ void operator()(const f32x4 (&acc)[2][2][4][2], const Unit& u, int wr, int wc, int fr, int fq, const Pre& P) const {
        const int row0 = u.pm * BM + wr * 64 + fr; const int pcol0 = u.pn * BM + wc * 32 + 8 * fq;
        const f32x4 (&sbv)[2][2] = P.sbv; const float (&sr)[2][4] = P.sr;
        if (u.pn < 4) {
            const float* gp = (u.pn < 2 ? gq : gk) + 8 * fq; const float qs = u.pn < 2 ? 0.125f * 1.4426950408889634f : 1.0f;
            f32x4 gv[2][2];
#pragma unroll
            for (int bj = 0; bj < 2; ++bj)
#pragma unroll
                for (int n = 0; n < 2; ++n) gv[bj][n] = *(const f32x4*)(gp + 32 * bj + 4 * n) * qs;
            const int lcol0 = u.pn * BM + wc * 64 + 8 * fq;
#pragma unroll
            for (int ai = 0; ai < 2; ++ai)
#pragma unroll
                for (int m = 0; m < 4; ++m) { const int r = row0 + ai * HALF + m * 16; bf16_t* rowp = O + (size_t)r * ldc + lcol0; const float s = sr[ai][m];
                    f32x4 x[2][2]; float ss = 0.f;
#pragma unroll
                    for (int bj = 0; bj < 2; ++bj)
#pragma unroll
                        for (int n = 0; n < 2; ++n) { const v4i32 iv = __builtin_bit_cast(v4i32, acc[ai][bj][m][n]); const f32x4 sc = sbv[bj][n] * s;
                            x[bj][n] = (f32x4){(float)iv[0] * sc[0], (float)iv[1] * sc[1], (float)iv[2] * sc[2], (float)iv[3] * sc[3]};
                            ss += (x[bj][n][0] * x[bj][n][0] + x[bj][n][1] * x[bj][n][1]) + (x[bj][n][2] * x[bj][n][2] + x[bj][n][3] * x[bj][n][3]); }
                    ss += __shfl_xor(ss, 16); ss += __shfl_xor(ss, 32);
                    const float rn = 1.0f / sqrtf(ss * (1.f / 64.f) + 1e-6f);
#pragma unroll
                    for (int bj = 0; bj < 2; ++bj) { const f32x4 v0 = x[bj][0] * gv[bj][0] * rn, v1 = x[bj][1] * gv[bj][1] * rn;
                        u32x4 w; w.x = cvt_pk_bf16(v0[0], v0[1]); w.y = cvt_pk_bf16(v0[2], v0[3]); w.z = cvt_pk_bf16(v1[0], v1[1]); w.w = cvt_pk_bf16(v1[2], v1[3]);
                        *(u32x4*)(rowp + bj * 32) = w; } }
        } else {
#pragma unroll
            for (int ai = 0; ai < 2; ++ai)
#pragma unroll
                for (int m = 0; m < 4; ++m) { const int r = row0 + ai * HALF + m * 16; const float s = sr[ai][m];
                    bf16_t* rowp; long bjstep;
                    if (u.pn >= 9) { const int cq = pcol0 - 2304; rowp = O + HGD + ((((long)(r >> 6) * 4 + (cq >> 8)) * 4 + ((cq >> 6) & 3)) * 8 + ((cq >> 3) & 7)) * 512 + (r & 63) * 8; bjstep = 2 * 8 * 512; }
                    else { rowp = O + (size_t)r * ldc + pcol0; bjstep = HALF; }
#pragma unroll
                    for (int bj = 0; bj < 2; ++bj) { const v4i32 i0 = __builtin_bit_cast(v4i32, acc[ai][bj][m][0]), i1 = __builtin_bit_cast(v4i32, acc[ai][bj][m][1]);
                        const f32x4 s0 = sbv[bj][0] * s, s1 = sbv[bj][1] * s;
                        u32x4 w; w.x = cvt_pk_bf16((float)i0[0] * s0[0], (float)i0[1] * s0[1]); w.y = cvt_pk_bf16((float)i0[2] * s0[2], (float)i0[3] * s0[3]);
                        w.z = cvt_pk_bf16((float)i1[0] * s1[0], (float)i1[1] * s1[1]); w.w = cvt_pk_bf16((float)i1[2] * s1[2], (float)i1[3] * s1[3]);
                        *(u32x4*)(rowp + bj * bjstep) = w; } }
        }
    }
};
__device__ __forceinline__ unsigned pk4_fp8(float a, float b, float c, float d) {
    a = __builtin_fminf(__builtin_fmaxf(a, -448.f), 448.f); b = __builtin_fminf(__builtin_fmaxf(b, -448.f), 448.f); c = __builtin_fminf(__builtin_fmaxf(c, -448.f), 448.f); d = __builtin_fminf(__builtin_fmaxf(d, -448.f), 448.f);
    unsigned w = 0u; w = __builtin_amdgcn_cvt_pk_fp8_f32(a, b, w, false); w = __builtin_amdgcn_cvt_pk_fp8_f32(c, d, w, true); return w; }
constexpr float S_Y = 16.f;
__device__ __forceinline__ unsigned pk4_i8y(float a, float b, float c, float d) {
    constexpr float MG = 12582912.f, LO = MG - 127.f, HI = MG + 127.f;
    const unsigned t0 = __builtin_bit_cast(unsigned, __builtin_amdgcn_fmed3f(__builtin_fmaf(a, S_Y, MG), LO, HI)), t1 = __builtin_bit_cast(unsigned, __builtin_amdgcn_fmed3f(__builtin_fmaf(b, S_Y, MG), LO, HI));
    const unsigned t2 = __builtin_bit_cast(unsigned, __builtin_amdgcn_fmed3f(__builtin_fmaf(c, S_Y, MG), LO, HI)), t3 = __builtin_bit_cast(unsigned, __builtin_amdgcn_fmed3f(__builtin_fmaf(d, S_Y, MG), LO, HI));
    return __builtin_amdgcn_perm(t1, t0, 0x0c0c0400u) | __builtin_amdgcn_perm(t3, t2, 0x04000c0cu); }
struct EpiSwiGLUi8 {
    static constexpr bool PERM = true, AFTER_DRAIN = false;
    unsigned char* H; int ldc; const float* sa; const float* sb; int sbstride; float hs;
    struct Pre { f32x4 sg0, sg1, su0, su1; float sr[2][4]; };
    __device__ __forceinline__ Pre pre(const Unit& u, int wr, int wc, int fr, int fq) const { Pre p;
        const int row0 = u.pm * BM + wr * 64 + fr; const float* sbp = sb + (size_t)u.ex * sbstride + u.pn * BM + wc * 32 + 8 * fq;
        p.sg0 = *(const f32x4*)(sbp); p.sg1 = *(const f32x4*)(sbp + 4); p.su0 = *(const f32x4*)(sbp + HALF); p.su1 = *(const f32x4*)(sbp + HALF + 4);
#pragma unroll
        for (int ai = 0; ai < 2; ++ai)
#pragma unroll
            for (int m = 0; m < 4; ++m) p.sr[ai][m] = sa[row0 + ai * HALF + m * 16];
        return p; }
    __device__ __forceinline__ void operator()(const f32x4 (&acc)[2][2][4][2], const Unit& u, int wr, int wc, int fr, int fq, const Pre& P) const {
        const int row0 = u.pm * BM + wr * 64 + fr; const int col0 = u.pn * HALF + wc * 32 + 8 * fq;
        const f32x4 sg0 = P.sg0 * 1.4426950408889634f, sg1 = P.sg1 * 1.4426950408889634f, su0 = P.su0 * (hs * 0.6931471805599453f), su1 = P.su1 * (hs * 0.6931471805599453f);
        const float (&sr)[2][4] = P.sr;
#pragma unroll
        for (int ai = 0; ai < 2; ++ai)
#pragma unroll
            for (int m = 0; m < 4; ++m) { const int r = row0 + ai * HALF + m * 16; unsigned char* rowp = H + (size_t)r * ldc + col0;
                const float s = sr[ai][m];
                const v4i32 ig0 = __builtin_bit_cast(v4i32, acc[ai][0][m][0]), ig1 = __builtin_bit_cast(v4i32, acc[ai][0][m][1]), iu0 = __builtin_bit_cast(v4i32, acc[ai][1][m][0]), iu1 = __builtin_bit_cast(v4i32, acc[ai][1][m][1]);
                const f32x4 g0 = __builtin_convertvector(ig0, f32x4) * (sg0 * s), g1 = __builtin_convertvector(ig1, f32x4) * (sg1 * s), u0 = __builtin_convertvector(iu0, f32x4) * su0, u1 = __builtin_convertvector(iu1, f32x4) * su1;
                f32x4 e0, e1;
#pragma unroll
                for (int j = 0; j < 4; ++j) { e0[j] = __builtin_amdgcn_exp2f(-g0[j]); e1[j] = __builtin_amdgcn_exp2f(-g1[j]); }
                e0 = e0 + 1.0f; e1 = e1 + 1.0f;
#pragma unroll
                for (int j = 0; j < 4; ++j) { e0[j] = __builtin_amdgcn_rcpf(e0[j]); e1[j] = __builtin_amdgcn_rcpf(e1[j]); }
                f32x4 h0 = g0 * e0 * u0, h1 = g1 * e1 * u1;
                typedef unsigned u32x2 __attribute__((ext_vector_type(2)));
                u32x2 w; w.x = pk4_fp8(h0[0], h0[1], h0[2], h0[3]); w.y = pk4_fp8(h1[0], h1[1], h1[2], h1[3]);
                *(u32x2*)rowp = w; }
    }
};
template <bool BASE_BF, bool ROWS = false> struct EpiResidB {
    static constexpr bool PERM = true, AFTER_DRAIN = false;
    const void* base; bf16_t* out; int ldc; float scale; const float* rs;
    struct Pre {}; __device__ __forceinline__ Pre pre(const Unit&, int, int, int, int) const { return Pre{}; }
    __device__ __forceinline__ void operator()(const f32x4 (&acc)[2][2][4][2], const Unit& u, int wr, int wc, int fr, int fq, const Pre&) const {
        const int row0 = u.pm * BM + wr * 64 + fr; const int col0 = u.pn * BM + wc * 32 + 8 * fq;
        float rsv[2][4];
#pragma unroll
        for (int ai = 0; ai < 2; ++ai)
#pragma unroll
            for (int m = 0; m < 4; ++m) rsv[ai][m] = ROWS ? this->scale * rs[row0 + ai * HALF + m * 16] : this->scale;
        constexpr int NA = 1;
#pragma unroll
        for (int a0 = 0; a0 < 2; a0 += NA) {
            typedef typename std::conditional<BASE_BF, u32x4, f32x4>::type raw_t;
            raw_t rb[NA][4][2][BASE_BF ? 1 : 2];
#pragma unroll
            for (int ai = a0; ai < a0 + NA; ++ai)
#pragma unroll
            for (int m = 0; m < 4; ++m) { const size_t off = (size_t)(row0 + ai * HALF + m * 16) * ldc + col0;
#pragma unroll
                for (int bj = 0; bj < 2; ++bj) {
                    if constexpr (BASE_BF) rb[ai - a0][m][bj][0] = *(const raw_t*)((const bf16_t*)base + off + bj * HALF);
                    else { rb[ai - a0][m][bj][0] = *(const raw_t*)((const float*)base + off + bj * HALF); rb[ai - a0][m][bj][BASE_BF ? 0 : 1] = *(const raw_t*)((const float*)base + off + bj * HALF + 4); } } }
#pragma unroll
            for (int ai = a0; ai < a0 + NA; ++ai)
#pragma unroll
            for (int m = 0; m < 4; ++m) { const size_t off = (size_t)(row0 + ai * HALF + m * 16) * ldc + col0; const float scale = rsv[ai][m];
#pragma unroll
                for (int bj = 0; bj < 2; ++bj) { f32x4 b0, b1;
                    if constexpr (BASE_BF) { const u32x4 r = __builtin_bit_cast(u32x4, rb[ai - a0][m][bj][0]);
                        b0 = (f32x4){__builtin_bit_cast(float, r.x << 16), __builtin_bit_cast(float, r.x & 0xffff0000u), __builtin_bit_cast(float, r.y << 16), __builtin_bit_cast(float, r.y & 0xffff0000u)};
                        b1 = (f32x4){__builtin_bit_cast(float, r.z << 16), __builtin_bit_cast(float, r.z & 0xffff0000u), __builtin_bit_cast(float, r.w << 16), __builtin_bit_cast(float, r.w & 0xffff0000u)}; }
                    else { b0 = __builtin_bit_cast(f32x4, rb[ai - a0][m][bj][0]); b1 = __builtin_bit_cast(f32x4, rb[ai - a0][m][bj][BASE_BF ? 0 : 1]); }
                    const f32x4 v0 = b0 + scale * acc[ai][bj][m][0], v1 = b1 + scale * acc[ai][bj][m][1];
                    u32x4 w; w.x = cvt_pk_bf16(v0[0], v0[1]); w.y = cvt_pk_bf16(v0[2], v0[3]); w.z = cvt_pk_bf16(v1[0], v1[1]); w.w = cvt_pk_bf16(v1[2], v1[3]);
                    *(u32x4*)(out + off + bj * HALF) = w; } } }
    }
};
template <bool BASE_BF> struct EpiResidI8 {
    static constexpr bool PERM = true, AFTER_DRAIN = false;
    const void* base; bf16_t* out; int ldc; float scale; const float* sb;
    struct Pre { f32x4 sbv[2][2]; };
    __device__ __forceinline__ Pre pre(const Unit& u, int wr, int wc, int fr, int fq) const { Pre p; const float* sbp = sb + u.pn * BM + wc * 32 + 8 * fq;
#pragma unroll
        for (int bj = 0; bj < 2; ++bj)
#pragma unroll
            for (int n = 0; n < 2; ++n) p.sbv[bj][n] = *(const f32x4*)(sbp + bj * HALF + 4 * n);
        return p; }
    __device__ __forceinline__ void operator()(const f32x4 (&acc)[2][2][4][2], const Unit& u, int wr, int wc, int fr, int fq, const Pre& P) const {
        const int row0 = u.pm * BM + wr * 64 + fr; const int col0 = u.pn * BM + wc * 32 + 8 * fq;
        f32x4 sv[2][2];
#pragma unroll
        for (int bj = 0; bj < 2; ++bj)
#pragma unroll
            for (int n = 0; n < 2; ++n) sv[bj][n] = P.sbv[bj][n] * scale;
        constexpr int NA = BASE_BF ? 2 : 1;
#pragma unroll
        for (int a0 = 0; a0 < 2; a0 += NA) {
            typedef typename std::conditional<BASE_BF, u32x4, f32x4>::type raw_t;
            raw_t rb[NA][4][2][BASE_BF ? 1 : 2];
#pragma unroll
            for (int ai = a0; ai < a0 + NA; ++ai)
#pragma unroll
            for (int m = 0; m < 4; ++m) { const size_t off = (size_t)(row0 + ai * HALF + m * 16) * ldc + col0;
#pragma unroll
                for (int bj = 0; bj < 2; ++bj) {
                    if constexpr (BASE_BF) rb[ai - a0][m][bj][0] = *(const raw_t*)((const bf16_t*)base + off + bj * HALF);
                    else { rb[ai - a0][m][bj][0] = *(const raw_t*)((const float*)base + off + bj * HALF); rb[ai - a0][m][bj][BASE_BF ? 0 : 1] = *(const raw_t*)((const float*)base + off + bj * HALF + 4); } } }
#pragma unroll
            for (int ai = a0; ai < a0 + NA; ++ai)
#pragma unroll
            for (int m = 0; m < 4; ++m) { const size_t off = (size_t)(row0 + ai * HALF + m * 16) * ldc + col0;
#pragma unroll
                for (int bj = 0; bj < 2; ++bj) { f32x4 b0, b1;
                    if constexpr (BASE_BF) { const u32x4 r = __builtin_bit_cast(u32x4, rb[ai - a0][m][bj][0]);
                        b0 = (f32x4){__builtin_bit_cast(float, r.x << 16), __builtin_bit_cast(float, r.x & 0xffff0000u), __builtin_bit_cast(float, r.y << 16), __builtin_bit_cast(float, r.y & 0xffff0000u)};
                        b1 = (f32x4){__builtin_bit_cast(float, r.z << 16), __builtin_bit_cast(float, r.z & 0xffff0000u), __builtin_bit_cast(float, r.w << 16), __builtin_bit_cast(float, r.w & 0xffff0000u)}; }
                    else { b0 = __builtin_bit_cast(f32x4, rb[ai - a0][m][bj][0]); b1 = __builtin_bit_cast(f32x4, rb[ai - a0][m][bj][BASE_BF ? 0 : 1]); }
                    const f32x4 v0 = b0 + sv[bj][0] * __builtin_convertvector(__builtin_bit_cast(v4i32, acc[ai][bj][m][0]), f32x4), v1 = b1 + sv[bj][1] * __builtin_convertvector(__builtin_bit_cast(v4i32, acc[ai][bj][m][1]), f32x4);
                    u32x4 w; w.x = cvt_pk_bf16(v0[0], v0[1]); w.y = cvt_pk_bf16(v0[2], v0[3]); w.z = cvt_pk_bf16(v1[0], v1[1]); w.w = cvt_pk_bf16(v1[2], v1[3]);
                    *(u32x4*)(out + off + bj * HALF) = w; } } }
    }
};
template <int KOUT, int KWS, size_t XBOFF, size_t WDELTA, size_t SDELTA, int LDC> struct EpiMoeDown {
    static constexpr bool PERM = true, AFTER_DRAIN = false;
    const int* idx; float scale;
    struct Pre {}; __device__ __forceinline__ Pre pre(const Unit&, int, int, int, int) const { return Pre{}; }
    __device__ __forceinline__ void operator()(const f32x4 (&acc)[2][2][4][2], const Unit& u, int wr, int wc, int fr, int fq, const Pre&) const {
        typedef const __attribute__((address_space(4))) unsigned char* KSeg;
        KSeg ks = (KSeg)__builtin_amdgcn_kernarg_segment_ptr(); asm volatile("" : "+s"(ks));
        float* const out = *(float* const __attribute__((address_space(4)))*)(ks + KOUT); const bf16_t* const xb = (const bf16_t*)(*(unsigned char* const __attribute__((address_space(4)))*)(ks + KWS) + XBOFF);
        const float* const wgt = (const float*)((const unsigned char*)idx + WDELTA); constexpr int ldc = LDC;
        { const int l_ = pg8_lane_id(); fr = l_ & 15; fq = l_ >> 4; }
        const int row0 = u.pm * BM + wr * 64 + fr; const int col0 = u.pn * BM + wc * 32 + 8 * fq;
        int tk[2][4]; float wg[2][4];
#pragma unroll
        for (int ai = 0; ai < 2; ++ai)
#pragma unroll
            for (int m = 0; m < 4; ++m) { tk[ai][m] = idx[row0 + ai * HALF + m * 16]; wg[ai][m] = wgt[row0 + ai * HALF + m * 16] * ((const float*)((const unsigned char*)idx + SDELTA))[row0 + ai * HALF + m * 16]; }
#pragma unroll
        for (int ai = 0; ai < 2; ++ai) {
            u32x4 rb[1][4][2];
#pragma unroll
            for (int m = 0; m < 4; ++m) { const int tv = tk[ai][m]; const size_t off = (size_t)(tv >= 0 ? (tv & 0x3fffffff) : 0) * ldc + col0;
#pragma unroll
                for (int bj = 0; bj < 2; ++bj) rb[0][m][bj] = *(const u32x4*)(xb + off + bj * HALF); }
#pragma unroll
            for (int m = 0; m < 4; ++m) {
                const int tv = tk[ai][m]; const float w = scale * wg[ai][m];
                if (tv >= 0) { const size_t off = (size_t)(tv & 0x3fffffff) * ldc + col0;
                    if (tv >> 30) {
#pragma unroll
                        for (int bj = 0; bj < 2; ++bj) { const u32x4 r = rb[0][m][bj];
                            const f32x4 b0 = (f32x4){__builtin_bit_cast(float, r.x << 16), __builtin_bit_cast(float, r.x & 0xffff0000u), __builtin_bit_cast(float, r.y << 16), __builtin_bit_cast(float, r.y & 0xffff0000u)};
                            const f32x4 b1 = (f32x4){__builtin_bit_cast(float, r.z << 16), __builtin_bit_cast(float, r.z & 0xffff0000u), __builtin_bit_cast(float, r.w << 16), __builtin_bit_cast(float, r.w & 0xffff0000u)};
                            const f32x4 v0 = b0 + w * acc[ai][bj][m][0], v1 = b1 + w * acc[ai][bj][m][1];
                            u32x4 o; o.x = cvt_pk_bf16(v0[0], v0[1]); o.y = cvt_pk_bf16(v0[2], v0[3]); o.z = cvt_pk_bf16(v1[0], v1[1]); o.w = cvt_pk_bf16(v1[2], v1[3]);
                            *(u32x4*)(const_cast<bf16_t*>(xb) + off + bj * HALF) = o; }
                    } else {
#pragma unroll
                        for (int bj = 0; bj < 2; ++bj) { const u32x4 r = rb[0][m][bj];
                            const f32x4 b0 = (f32x4){__builtin_bit_cast(float, r.x << 16), __builtin_bit_cast(float, r.x & 0xffff0000u), __builtin_bit_cast(float, r.y << 16), __builtin_bit_cast(float, r.y & 0xffff0000u)};
                            const f32x4 b1 = (f32x4){__builtin_bit_cast(float, r.z << 16), __builtin_bit_cast(float, r.z & 0xffff0000u), __builtin_bit_cast(float, r.w << 16), __builtin_bit_cast(float, r.w & 0xffff0000u)};
                            __builtin_nontemporal_store(b0 + w * acc[ai][bj][m][0], (f32x4*)(out + off + bj * HALF)); __builtin_nontemporal_store(b1 + w * acc[ai][bj][m][1], (f32x4*)(out + off + bj * HALF + 4)); }
                    } } } }
    }
};
struct MoeOrder {
    StaticOrder base; const int* pexp; long estride; int nlate, nA;
    __device__ __forceinline__ bool next(int i, Unit& u) const {
        int L;
        if (nlate == 0) L = i * base.G + base.c;
        else { const int ne = base.G - nlate; if (base.c < ne) L = i < nA ? i * ne + base.c : nA * ne + (i - nA) * base.G + base.c; else L = nA * ne + i * base.G + base.c; }
        if (!base.at(L, u)) return false;
        u.ex = __builtin_amdgcn_readfirstlane(__hip_atomic_load(pexp + u.pm, __ATOMIC_RELAXED, __HIP_MEMORY_SCOPE_AGENT)); u.boff = (long)u.ex * estride; return true; }
    __device__ __forceinline__ void a_ready(const Unit&) const {}
    __device__ __forceinline__ void done(const Unit&) const {}
};

template <class Epi, class Sched, bool ALIGN_EPI = false, bool SP2 = false, bool I8 = false, bool F8 = false>
__device__ __forceinline__ void gemm_phase(PG8_LAS unsigned char* lds, const Gemm g, const Sched& S, const Epi& E, const int wid_in  ) {
    const int lane = pg8_lane_id(), wid = wid_in, tid = wid * 64 + lane, wr = wid >> 2, wc = wid & 3, fr = lane & 15, fq = lane >> 4;
    const int K = g.K, nt = K / BK;
    unsigned voffA[2], voffB[2];
#pragma unroll
    for (int i = 0; i < 2; ++i) { int R, C; stage_rc(tid * 16 + i * 8192, R, C); const int Rb = Epi::PERM ? ((R & ~31) + perm32(R & 31)) : R;
        voffA[i] = (unsigned)(R * K + C) * 2u; voffB[i] = (unsigned)(Rb * K + C) * 2u; }
    const size_t kstep = (size_t)(BK * 2);
    const size_t hstep = (size_t)HALF * K * 2;
    const size_t tstep = 2 * hstep;
    const unsigned ldsw = (unsigned)wid * 1024u;
    const unsigned ldsu = (unsigned)__builtin_amdgcn_readfirstlane((int)((unsigned)(size_t)lds + ldsw));
    const int aoff = lds_byte(wr * 64 + fr, fq * 8), boff = lds_byte(wc * 32 + fr, fq * 8);
#define PG8_SA(b, h) (((b) * 2 + (h)) * HTB)
#define PG8_SB(b, h) ((4 + (b) * 2 + (h)) * HTB)
#define PG8_STAGE(bufoff, gbase, voff) do { _Pragma("unroll") for (int _i = 0; _i < 2; ++_i) { unsigned keep_; \
        asm volatile("s_mov_b32 %0, m0\n\ts_mov_b32 m0, %3\n\ts_nop 4\n\tglobal_load_lds_dwordx4 %1, %2\n\ts_mov_b32 m0, %0" : "=&s"(keep_) : "v"((voff)[_i]), "s"((const void*)(gbase)), "s"(ldsu + (unsigned)((bufoff) + _i * 8192)) : "memory"); } } while (0)
#define PG8_LDA(dst, b, h) do { _Pragma("unroll") for (int m = 0; m < 4; ++m) _Pragma("unroll") for (int k = 0; k < 2; ++k) dst[m][k] = *(const PG8_LAS bf16x8*)(lds + PG8_SA(b, h) + aoff + m * 2048 + k * 1024); } while (0)
#define PG8_LDB(dst, b, h) do { _Pragma("unroll") for (int n = 0; n < 2; ++n) _Pragma("unroll") for (int k = 0; k < 2; ++k) dst[n][k] = *(const PG8_LAS bf16x8*)(lds + PG8_SB(b, h) + boff + n * 2048 + k * 1024); } while (0)
#define PG8_CAT8(x) __builtin_shufflevector(__builtin_bit_cast(v4i32, x[0]), __builtin_bit_cast(v4i32, x[1]), 0, 1, 2, 3, 4, 5, 6, 7)
#define PG8_MMA(ai, bj, At, Bt) do { if constexpr (F8) { __builtin_amdgcn_sched_barrier(0); __builtin_amdgcn_s_setprio(1); _Pragma("unroll") for (int m = 0; m < 4; ++m) _Pragma("unroll") for (int n = 0; n < 2; ++n) \
        acc[ai][bj][m][n] = __builtin_amdgcn_mfma_scale_f32_16x16x128_f8f6f4(PG8_CAT8(Bt[n]), PG8_CAT8(At[m]), acc[ai][bj][m][n], 0, 0, 0, 0, 0, 0); __builtin_amdgcn_s_setprio(0); __builtin_amdgcn_sched_barrier(0); } else { \
        __builtin_amdgcn_s_setprio(1); _Pragma("unroll") for (int m = 0; m < 4; ++m) _Pragma("unroll") for (int n = 0; n < 2; ++n) _Pragma("unroll") for (int k = 0; k < 2; ++k) \
        { if constexpr (I8) acc[ai][bj][m][n] = __builtin_bit_cast(f32x4, __builtin_amdgcn_mfma_i32_16x16x64_i8(__builtin_bit_cast(v4i32, Bt[n][k]), __builtin_bit_cast(v4i32, At[m][k]), __builtin_bit_cast(v4i32, acc[ai][bj][m][n]), 0, 0, 0)); \
        else acc[ai][bj][m][n] = __builtin_amdgcn_mfma_f32_16x16x32_bf16(Bt[n][k], At[m][k], acc[ai][bj][m][n], 0, 0, 0); } __builtin_amdgcn_s_setprio(0); } } while (0)
#define PG8_WAIT_V(n) asm volatile("s_waitcnt vmcnt(" #n ")" ::: "memory")
#define PG8_WAIT_L(n) asm volatile("s_waitcnt lgkmcnt(" #n ")" ::: "memory")
#define PG8_BAR __builtin_amdgcn_s_barrier()
#define PG8_SCHED __builtin_amdgcn_sched_barrier(0)
    Unit cur, nxt; int ui = 0;
    if (!S.next(0, cur)) return;
    f32x4 acc[2][2][4][2];
#pragma unroll
    for (int a = 0; a < 2; ++a)
#pragma unroll
        for (int b = 0; b < 2; ++b)
#pragma unroll
            for (int m = 0; m < 4; ++m)
#pragma unroll
                for (int n = 0; n < 2; ++n) acc[a][b][m][n] = (f32x4){0.f, 0.f, 0.f, 0.f};
    bf16x8 At[4][2], B0[2][2], B1[2][2];
    const char* cA = (const char*)g.A + (size_t)cur.pm * tstep; const char* cB = (const char*)g.Bt + (size_t)cur.pn * tstep + cur.boff;
    S.a_ready(cur);
    typename Epi::Pre pre = E.pre(cur, wr, wc, fr, fq);
    if constexpr (SP2) {
        PG8_STAGE(PG8_SB(0, 0), cB, voffB); PG8_STAGE(PG8_SB(0, 1), cB + hstep, voffB); PG8_STAGE(PG8_SA(0, 0), cA, voffA); PG8_STAGE(PG8_SA(0, 1), cA + hstep, voffA);
        if (wr == 1) PG8_BAR;
        PG8_WAIT_V(2); PG8_BAR;
        PG8_STAGE(PG8_SB(1, 0), cB + kstep, voffB); PG8_STAGE(PG8_SA(1, 0), cA + kstep, voffA); PG8_STAGE(PG8_SB(1, 1), cB + hstep + kstep, voffB);
        PG8_WAIT_V(6); PG8_BAR;
    } else {
        PG8_STAGE(PG8_SB(0, 0), cB, voffB); PG8_STAGE(PG8_SA(0, 0), cA, voffA); PG8_STAGE(PG8_SB(0, 1), cB + hstep, voffB); PG8_STAGE(PG8_SA(0, 1), cA + hstep, voffA);
        if (wr == 1) PG8_BAR;
        PG8_WAIT_V(4); PG8_BAR;
        PG8_STAGE(PG8_SB(1, 0), cB + kstep, voffB); PG8_STAGE(PG8_SA(1, 0), cA + kstep, voffA); PG8_STAGE(PG8_SB(1, 1), cB + hstep + kstep, voffB);
        PG8_WAIT_V(6); PG8_BAR;
    }
    for (;;) {
        const bool has_next = S.next(ui + 1, nxt);
        const char* nA = has_next ? (const char*)g.A + (size_t)nxt.pm * tstep : cA; const char* nB = has_next ? (const char*)g.Bt + (size_t)nxt.pn * tstep + nxt.boff : cB;
        for (int t = 0; t < nt; t += 2) {
            const bool last = (t == nt - 2);
            const char* a1 = cA + (size_t)(t + 1) * kstep;
            const char* a2 = last ? nA : cA + (size_t)(t + 2) * kstep; const char* b2 = last ? nB : cB + (size_t)(t + 2) * kstep;
            const char* a3 = a2 + kstep; const char* b3 = b2 + kstep;
            if (last && has_next) S.a_ready(nxt);
            if constexpr (SP2) {
            PG8_LDB(B0, 0, 0); PG8_LDB(B1, 0, 1); PG8_SCHED; PG8_LDA(At, 0, 0); PG8_STAGE(PG8_SA(1, 1), a1 + hstep, voffA);
            PG8_WAIT_V(8); PG8_WAIT_L(0); PG8_BAR; PG8_MMA(0, 0, At, B0); PG8_MMA(0, 1, At, B1); PG8_BAR; PG8_SCHED;
            PG8_LDA(At, 0, 1); PG8_STAGE(PG8_SB(0, 0), b2, voffB); PG8_STAGE(PG8_SB(0, 1), b2 + hstep, voffB); PG8_STAGE(PG8_SA(0, 0), a2, voffA);
            PG8_WAIT_V(8); PG8_WAIT_L(0); PG8_BAR; PG8_MMA(1, 0, At, B0); PG8_MMA(1, 1, At, B1); PG8_BAR; PG8_SCHED;
            PG8_LDB(B0, 1, 0); PG8_LDB(B1, 1, 1); PG8_SCHED; PG8_LDA(At, 1, 0); PG8_STAGE(PG8_SA(0, 1), a2 + hstep, voffA);
            PG8_WAIT_V(8); PG8_WAIT_L(0); PG8_BAR; PG8_MMA(0, 0, At, B0); PG8_MMA(0, 1, At, B1); PG8_BAR; PG8_SCHED;
            PG8_LDA(At, 1, 1); PG8_STAGE(PG8_SB(1, 0), b3, voffB); PG8_STAGE(PG8_SB(1, 1), b3 + hstep, voffB); PG8_STAGE(PG8_SA(1, 0), a3, voffA);
            PG8_WAIT_V(8); PG8_WAIT_L(0); PG8_BAR; PG8_MMA(1, 0, At, B0); PG8_MMA(1, 1, At, B1); PG8_BAR; PG8_SCHED;
            } else {
            PG8_LDB(B0, 0, 0); PG8_SCHED; PG8_LDA(At, 0, 0); PG8_STAGE(PG8_SA(1, 1), a1 + hstep, voffA);
            PG8_WAIT_L(8); PG8_BAR; PG8_WAIT_L(0); PG8_MMA(0, 0, At, B0); PG8_BAR; PG8_SCHED;
            PG8_LDB(B1, 0, 1); PG8_STAGE(PG8_SB(0, 0), b2, voffB);
            PG8_BAR; PG8_WAIT_L(0); PG8_MMA(0, 1, At, B1); PG8_BAR;
            PG8_LDA(At, 0, 1); PG8_STAGE(PG8_SA(0, 0), a2, voffA);
            PG8_BAR; PG8_WAIT_L(0); PG8_MMA(1, 0, At, B0); PG8_BAR; PG8_SCHED;
            PG8_STAGE(PG8_SB(0, 1), b2 + hstep, voffB);
            PG8_WAIT_V(6); PG8_BAR; PG8_MMA(1, 1, At, B1); PG8_BAR;
            PG8_LDB(B0, 1, 0); PG8_SCHED; PG8_LDA(At, 1, 0); PG8_STAGE(PG8_SA(0, 1), a2 + hstep, voffA);
            PG8_WAIT_L(8); PG8_BAR; PG8_WAIT_L(0); PG8_MMA(0, 0, At, B0); PG8_BAR; PG8_SCHED;
            PG8_LDB(B1, 1, 1); PG8_STAGE(PG8_SB(1, 0), b3, voffB);
            PG8_BAR; PG8_WAIT_L(0); PG8_MMA(0, 1, At, B1); PG8_BAR;
            PG8_LDA(At, 1, 1); PG8_STAGE(PG8_SA(1, 0), a3, voffA);
            PG8_BAR; PG8_WAIT_L(0); PG8_MMA(1, 0, At, B0); PG8_BAR; PG8_SCHED;
            PG8_STAGE(PG8_SB(1, 1), b3 + hstep, voffB);
            PG8_WAIT_V(6); PG8_BAR; PG8_MMA(1, 1, At, B1); PG8_BAR;
            }
        }
        if constexpr (ALIGN_EPI) { if (wr == 0) PG8_BAR; }
        if constexpr (!Epi::AFTER_DRAIN) { E(acc, cur, wr, wc, fr, fq, pre); S.done(cur); }
        if (!has_next) break;
#pragma unroll
        for (int a = 0; a < 2; ++a)
#pragma unroll
            for (int b = 0; b < 2; ++b)
#pragma unroll
                for (int m = 0; m < 4; ++m)
#pragma unroll
                    for (int n = 0; n < 2; ++n) acc[a][b][m][n] = (f32x4){0.f, 0.f, 0.f, 0.f};
        cur = nxt; cA = nA; cB = nB; ++ui; pre = E.pre(cur, wr, wc, fr, fq);
        if constexpr (ALIGN_EPI) { if (wr == 1) PG8_BAR; }
    }
    PG8_WAIT_V(0);
    if constexpr (!ALIGN_EPI) { if (wr == 0) PG8_BAR; }
    PG8_BAR;
    if constexpr (Epi::AFTER_DRAIN) { E.fused(acc, cur, wr, wc, fr, fq, lds, wid, lane); S.done(cur); }
#undef PG8_SA
#undef PG8_SB
#undef PG8_STAGE
#undef PG8_LDA
#undef PG8_LDB
#undef PG8_MMA
#undef PG8_CAT8
#undef PG8_WAIT_V
#undef PG8_WAIT_L
#undef PG8_BAR
#undef PG8_SCHED
}
}
constexpr int NWAVES = 8;
constexpr int BATCH = 4, SEQ = 8192, DM = 1024, M = BATCH * SEQ;
constexpr int DIN = 3336;
constexpr int ZP = 2304;
constexpr int NZ = 3328;
constexpr int FF = 3584, NE = 8;
constexpr int CH_PANELS = 160, CH_ROWS = CH_PANELS * 256;
constexpr float EPS = 1e-6f;
constexpr float S_HID = 0.125f, S_WDN = 512.f;
constexpr int ZQ = 0, ZK = 512, ZV = 1024, ZCX = 1536, ZCB = 1792, ZCC = 2048, ZRQ = 2304, ZRF = 2560, ZRI = 2816, ZRG = 3072;
constexpr int MAXROWS = 2 * (M + NE * 256);
constexpr int MAXPANELS = MAXROWS / 256;

constexpr size_t MiB = 1u << 20;
constexpr size_t WS_CTL = 0, CTL_ZERO_BYTES = 160 * 1024;
constexpr size_t WS_TAB = 1 * MiB;
constexpr size_t T_LSIG = WS_TAB, T_DCUM = WS_TAB + 1 * MiB;
constexpr size_t T_TOPE = WS_TAB + 2 * MiB, T_TOPW = T_TOPE + 256 * 1024;
constexpr size_t T_CNT = T_TOPW + 256 * 1024, T_CBASE = T_CNT + 32 * 1024;
constexpr size_t T_IDX = WS_TAB + 3 * MiB, T_WGT = T_IDX + 512 * 1024;
constexpr size_t T_PEXP = WS_TAB + 4 * MiB, T_META = T_PEXP + 4096, T_LB = T_META + 4096, T_JT0 = T_LB + 4096;
constexpr size_t T_DK2 = WS_TAB + 5 * MiB;
constexpr size_t T_SA = WS_TAB + 6 * MiB, T_SAS = T_SA + 128 * 1024, T_SBF = T_SAS + 384 * 1024, T_SBM = T_SBF + 32 * 1024, T_SBIN = T_SBM + 256 * 1024, T_SBO = T_SBIN + 32 * 1024;
constexpr size_t WS_W0 = 9 * MiB;
constexpr size_t W_IN = WS_W0, W_IN_STRIDE = (size_t)NZ * DM * 2;
constexpr size_t W_OUT = WS_W0 + 13 * MiB, W_OUT_STRIDE = 2 * MiB;
constexpr size_t W_FGU = WS_W0 + 17 * MiB, W_FD = WS_W0 + 31 * MiB;
constexpr size_t WS_S = 49 * MiB;
constexpr size_t WS_HG = WS_S + (size_t)32768 * ZP * 2;
constexpr size_t W_MGU = 449 * MiB, W_MGU_STRIDE = (size_t)2 * FF * DM, W_MD = W_MGU + 56 * MiB, W_MD_STRIDE = (size_t)DM * FF;
constexpr size_t WS_XS = WS_S + 112 * MiB;
constexpr size_t WS_A = 257 * MiB;
constexpr size_t WS_B = 321 * MiB;
constexpr size_t WS_XB = 385 * MiB;
constexpr size_t WS_HD = WS_S;
constexpr size_t WS_HT = WS_A, WS_HM = WS_A + 14 * MiB;
constexpr size_t WS_END = 533 * MiB;
static_assert(WS_HM + (size_t)128 * 256 * FF <= WS_XB && WS_HD + (size_t)M * FF <= WS_A && (size_t)16 * 256 * FF <= WS_HM - WS_HT && WS_HG + (size_t)M * 1024 * 2 <= WS_A && W_MGU >= WS_XB + (size_t)M * DM * 2 && W_MD + 8 * W_MD_STRIDE <= WS_END && WS_XS + (size_t)MAXROWS * DM <= WS_A && W_FD + (size_t)DM * FF * 2 <= WS_S && T_SBIN + 2 * NZ * 4 <= T_SBO && T_SBO + 2 * DM * 4 <= WS_W0, "d_ws map");
constexpr size_t CMAX_OFF = 256 * 1024, CMAXIN_OFF = 768 * 1024;
constexpr size_t CNT_CTL_OFF = 128 * 1024;
constexpr int CW_BAR = 4096;

constexpr int RING_OFF = 0, RING_BYTES = 131072;
constexpr int LDSCTL_OFF = RING_BYTES, MISC_OFF = LDSCTL_OFF + 320;
constexpr int LDS_BYTES = 147456;

#define GAS __attribute__((address_space(1)))
#define LAS __attribute__((address_space(3)))
typedef unsigned short bf16;
typedef unsigned v4u __attribute__((ext_vector_type(4)));
typedef unsigned v2u __attribute__((ext_vector_type(2)));
typedef float f32x4 __attribute__((ext_vector_type(4)));
typedef GAS unsigned gu32;
#define RLX_AGENT __ATOMIC_RELAXED, __HIP_MEMORY_SCOPE_AGENT
#define LDS_WAIT() asm volatile("s_waitcnt lgkmcnt(0)" ::: "memory")
#define VM_WAIT() asm volatile("s_waitcnt vmcnt(0)" ::: "memory")
__device__ __forceinline__ unsigned pk2(float lo, float hi) { unsigned r; asm("v_cvt_pk_bf16_f32 %0, %1, %2" : "=v"(r) : "v"(lo), "v"(hi)); return r; }
__device__ __forceinline__ unsigned f2bf(float f) { return pk2(f, f) & 0xffffu; }
__device__ __forceinline__ float bf2f(unsigned short b) { return __builtin_bit_cast(float, (unsigned)b << 16); }
__device__ __forceinline__ float bflo(unsigned w) { return __builtin_bit_cast(float, w << 16); }
__device__ __forceinline__ float bfhi(unsigned w) { return __builtin_bit_cast(float, w & 0xffff0000u); }
__device__ __forceinline__ int ldi(const int* p) { return __hip_atomic_load(p, RLX_AGENT); }
#define DPPF(x, ctrl, rmask) __builtin_bit_cast(float, __builtin_amdgcn_update_dpp(0, __builtin_bit_cast(int, x), ctrl, rmask, 0xF, false))
__device__ __forceinline__ float wave_sum(float v) {
    v += DPPF(v, 0xB1, 0xF); v += DPPF(v, 0x4E, 0xF); v += DPPF(v, 0x141, 0xF); v += DPPF(v, 0x140, 0xF);
    v += DPPF(v, 0x142, 0xA); v += DPPF(v, 0x143, 0xC);
    return __builtin_bit_cast(float, __builtin_amdgcn_readlane(__builtin_bit_cast(int, v), 63));
}
__device__ __forceinline__ float wave_max_nonneg(float v) {
    v = fmaxf(v, DPPF(v, 0xB1, 0xF)); v = fmaxf(v, DPPF(v, 0x4E, 0xF)); v = fmaxf(v, DPPF(v, 0x141, 0xF)); v = fmaxf(v, DPPF(v, 0x140, 0xF));
    v = fmaxf(v, DPPF(v, 0x142, 0xA)); v = fmaxf(v, DPPF(v, 0x143, 0xC));
    return __builtin_bit_cast(float, __builtin_amdgcn_readlane(__builtin_bit_cast(int, v), 63));
}

#define XB_TMO      128
#define XB_XCNT(j)  (256  + 64 * (j))
#define XB_XSUB(j)  (1280 + 64 * (j))
#define XB_XGEN(j)  (2304 + 64 * (j))
#define XB_TOP      3328
#define XB_TOPGEN   3392
#define XCD_BAR_WORDS 3456
#define XB_SPIN_CAP (1u << 18)

__device__ __forceinline__ unsigned xb_ld(unsigned* p)              { return __hip_atomic_load(p, __ATOMIC_RELAXED, __HIP_MEMORY_SCOPE_AGENT); }
__device__ __forceinline__ unsigned xb_add(unsigned* p, unsigned v) { return __hip_atomic_fetch_add(p, v, __ATOMIC_RELAXED, __HIP_MEMORY_SCOPE_AGENT); }
__device__ __forceinline__ unsigned xb_xcc_id() { return (unsigned)__builtin_amdgcn_s_getreg((3 << 11) | 20) & 0xFu; }
#define XB_SPIN(cond, bar) do { unsigned _sp = 0; while (cond) { __builtin_amdgcn_s_sleep(1); \
    if ((++_sp & 255u) == 0u) { if (xb_ld(&(bar)[XB_TMO])) break; if (_sp > XB_SPIN_CAP) { atomicAdd(&(bar)[XB_TMO], 1u); break; } } } } while (0)

struct XcdBarrier {
    unsigned* bar; unsigned x;
    volatile LAS unsigned* st;
};

__device__ __forceinline__ XcdBarrier xcd_barrier_post(unsigned* bar, volatile LAS unsigned* st) {
    XcdBarrier b; b.bar = bar; b.x = xb_xcc_id(); b.st = st;
    if (threadIdx.x == 0) (void)xb_add(&bar[XB_XCNT(b.x)], 1u);
    return b;
}
__device__ __forceinline__ void xcd_barrier_complete(unsigned* bar, unsigned x, unsigned& nloc, unsigned& nx) {
    const unsigned G = gridDim.x * gridDim.y * gridDim.z;
    unsigned sum, cnt, mine, sp = 0u;
    for (;;) {
        sum = 0u; cnt = 0u; mine = 0u;
#pragma unroll
        for (unsigned j = 0; j < 16; ++j) { const unsigned c = xb_ld(&bar[XB_XCNT(j)]); sum += c; cnt += (c > 0u) ? 1u : 0u; mine = (j == x) ? c : mine; }
        if (sum == G) break;
        __builtin_amdgcn_s_sleep(1);
        if ((++sp & 255u) == 0u) { if (xb_ld(&bar[XB_TMO])) break; if (sp > XB_SPIN_CAP) { atomicAdd(&bar[XB_TMO], 1u); break; } }
    }
    nloc = mine > 0u ? mine : 1u; nx = cnt > 0u ? cnt : 1u;
}

__device__ __forceinline__ void xcd_barrier(const XcdBarrier& b) {
    asm volatile("s_waitcnt vmcnt(0)" ::: "memory");
    __syncthreads();
    if (threadIdx.x == 0) {
        unsigned* bar = b.bar;
        __builtin_amdgcn_s_waitcnt(0);
        unsigned nloc = b.st[0], nx = b.st[1];
        if (nloc == 0u) { xcd_barrier_complete(bar, b.x, nloc, nx); b.st[0] = nloc; b.st[1] = nx; }
        const unsigned old = xb_add(&bar[XB_XSUB(b.x)], 1u);
        const unsigned gen = old / nloc;
        if (old + 1u == (gen + 1u) * nloc) {
            __builtin_amdgcn_fence(__ATOMIC_RELEASE, "agent");
            asm volatile("s_waitcnt vmcnt(0)" ::: "memory");
            const unsigned og = xb_add(&bar[XB_TOP], 1u);
            const unsigned tg = og / nx;
            if (og + 1u == (tg + 1u) * nx) xb_add(&bar[XB_TOPGEN], 1u);
            else XB_SPIN(xb_ld(&bar[XB_TOPGEN]) == tg, bar);
            __builtin_amdgcn_fence(__ATOMIC_ACQUIRE, "agent");
            xb_add(&bar[XB_XGEN(b.x)], 1u);
            asm volatile("s_waitcnt vmcnt(0)" ::: "memory");
        } else {
            XB_SPIN(xb_ld(&bar[XB_XGEN(b.x)]) == gen, bar);
            __builtin_amdgcn_fence(__ATOMIC_ACQUIRE, "agent");
            asm volatile("s_waitcnt vmcnt(0)" ::: "memory");
        }
    }
    __syncthreads();
}
#include <hip/hip_bf16.h>
#include <cmath>
namespace attn_body {
using bf16=__hip_bfloat16;
using bf16x8=__attribute__((ext_vector_type(8)))short;
using s16x4=__attribute__((ext_vector_type(4)))short;
using f32x16=__attribute__((ext_vector_type(16)))float;
using u32x4=__attribute__((ext_vector_type(4)))unsigned;
constexpr int BATCH=4,NHEAD=8,SEQ=8192,D=64,PQ=2304,PO=1024;
constexpr int NW=8,QBLK=32,QB=QBLK*NW,KVBLK=64,NQB=SEQ/QB;
constexpr int ATTN_UNIT_ROWS=QB;
__device__ __forceinline__ int crow(int r,int hi){return (r&3)+8*(r>>2)+4*hi;}
#define SBAR() __builtin_amdgcn_sched_barrier(0)
__device__ __forceinline__ void cmask(f32x16&p0,f32x16&p1,int jb,int qrel,int hi){
  const float NEG=-INFINITY; int kb=64*jb+4*hi;
  #pragma unroll
  for(int r=0;r<16;++r){int kv=kb+(r&3)+8*(r>>2); if(kv>qrel)p0[r]=NEG; if(kv+32>qrel)p1[r]=NEG;}
}

constexpr int NSLOT=3, SLOTB=8192;
constexpr int LDS_QPF=98304;
constexpr int LDS_K=0, LDS_V=NSLOT*SLOTB, LDS_WS=2*NSLOT*SLOTB, LDS_OST=LDS_WS+NW*64*4, LDS_DK=LDS_OST+NW*4096, LDS_BYTES=LDS_DK+NW*NSLOT*256;
constexpr float C2=0.125f*1.4426950408889634f;
__device__ __forceinline__ void glds16(const void*gsrc,unsigned lds_dst){unsigned keep;
  asm volatile("s_mov_b32 %0, m0\n\ts_mov_b32 m0, %2\n\ts_nop 0\n\tglobal_load_lds_dwordx4 %1, off\n\ts_mov_b32 m0, %0":"=&s"(keep):"v"(gsrc),"s"(lds_dst):"memory");}
__device__ __forceinline__ void glds4(const void*gsrc,unsigned lds_dst){unsigned keep;
  asm volatile("s_mov_b32 %0, m0\n\ts_mov_b32 m0, %2\n\ts_nop 0\n\tglobal_load_lds_dword %1, off\n\ts_mov_b32 m0, %0":"=&s"(keep):"v"(gsrc),"s"(lds_dst):"memory");}
__device__ __forceinline__ void glds16s(const void*sbase,unsigned voff,unsigned lds_dst){unsigned keep;
  asm volatile("s_mov_b32 %0, m0\n\ts_mov_b32 m0, %3\n\ts_nop 4\n\tglobal_load_lds_dwordx4 %1, %2\n\ts_mov_b32 m0, %0":"=&s"(keep):"v"(voff),"s"(sbase),"s"(lds_dst):"memory");}
__device__ __forceinline__ void glds4s(const void*sbase,unsigned voff,unsigned lds_dst){unsigned keep;
  asm volatile("s_mov_b32 %0, m0\n\ts_mov_b32 m0, %3\n\ts_nop 4\n\tglobal_load_lds_dword %1, %2\n\ts_mov_b32 m0, %0":"=&s"(keep):"v"(voff),"s"(sbase),"s"(lds_dst):"memory");}
__device__ __forceinline__ float max3f(float a,float b,float c){float r;asm("v_max3_f32 %0, %1, %2, %3":"=v"(r):"v"(a),"v"(b),"v"(c));return r;}
__device__ __forceinline__ float max2f(float a,float b){float r;asm("v_max_f32_e32 %0, %1, %2":"=v"(r):"v"(a),"v"(b));return r;}
__device__ __forceinline__ float fadd_s(float a,float b){float r;asm("v_add_f32_e32 %0, %1, %2":"=v"(r):"v"(a),"v"(b));return r;}
__device__ __forceinline__ float fsub_s(float a,float b){float r;asm("v_sub_f32_e32 %0, %1, %2":"=v"(r):"v"(a),"v"(b));return r;}
typedef float f32x2_t __attribute__((ext_vector_type(2))); typedef __bf16 bf16x2_t __attribute__((ext_vector_type(2)));
__device__ __forceinline__ unsigned cvtpk_s(float lo,float hi){f32x2_t v={lo,hi};bf16x2_t b=__builtin_convertvector(v,bf16x2_t);return __builtin_bit_cast(unsigned,b);}
#define WAIT_BAR(N) asm volatile("s_waitcnt vmcnt(" #N ") lgkmcnt(0)\n\ts_barrier":::"memory")

__device__ __forceinline__ void qkt(f32x16&p0,f32x16&p1,const char*Kslot,const bf16x8*qr,int r32,int hi){ const f32x16 zz=f32x16{};
  const char*kb=Kslot+hi*1024+r32*16;
  #pragma unroll
  for(int d0=0;d0<4;++d0){
    const bf16x8 b0=*reinterpret_cast<const bf16x8*>(kb+d0*2048);
    const bf16x8 b1=*reinterpret_cast<const bf16x8*>(kb+d0*2048+512);
    if(d0==0){p0=__builtin_amdgcn_mfma_f32_32x32x16_bf16(b0,qr[0],zz,0,0,0);p1=__builtin_amdgcn_mfma_f32_32x32x16_bf16(b1,qr[0],zz,0,0,0);}
    else{p0=__builtin_amdgcn_mfma_f32_32x32x16_bf16(b0,qr[d0],p0,0,0,0);p1=__builtin_amdgcn_mfma_f32_32x32x16_bf16(b1,qr[d0],p1,0,0,0);}}
}
typedef __attribute__((address_space(3))) const char* lds_cptr;
typedef short v4i16_t __attribute__((ext_vector_type(4)));
__device__ __forceinline__ void kload8(bf16x8*kf,lds_cptr kp){
  kf[0]=*(const __attribute__((address_space(3))) bf16x8*)(kp);      kf[1]=*(const __attribute__((address_space(3))) bf16x8*)(kp+512);
  kf[2]=*(const __attribute__((address_space(3))) bf16x8*)(kp+2048); kf[3]=*(const __attribute__((address_space(3))) bf16x8*)(kp+2560);
  kf[4]=*(const __attribute__((address_space(3))) bf16x8*)(kp+4096); kf[5]=*(const __attribute__((address_space(3))) bf16x8*)(kp+4608);
  kf[6]=*(const __attribute__((address_space(3))) bf16x8*)(kp+6144); kf[7]=*(const __attribute__((address_space(3))) bf16x8*)(kp+6656);
}
__device__ __forceinline__ void kload2(bf16x8*kf,lds_cptr kp,int j){ kf[2*j]=*(const __attribute__((address_space(3))) bf16x8*)(kp+j*2048); kf[2*j+1]=*(const __attribute__((address_space(3))) bf16x8*)(kp+j*2048+512); }
__device__ __forceinline__ s16x4 vtr(lds_cptr p){ return __builtin_bit_cast(s16x4,__builtin_amdgcn_ds_read_tr16_b64_v4i16((__attribute__((address_space(3))) v4i16_t*)p)); }
__device__ __forceinline__ float rowmax(const f32x16&p0,const f32x16&p1){
  float a=max3f(p0[0],p0[1],p1[0]),b=max3f(p0[2],p0[3],p1[1]);a=max3f(a,p1[2],p1[3]);
  #pragma unroll
  for(int r=4;r<16;r+=4){a=max3f(a,p0[r],p0[r+1]);b=max3f(b,p0[r+2],p0[r+3]);a=max3f(a,p1[r],p1[r+1]);b=max3f(b,p1[r+2],p1[r+3]);}
  const float m=max2f(a,b);
  auto rr=__builtin_amdgcn_permlane32_swap(__float_as_uint(m),__float_as_uint(m),false,false);
  return max2f(__uint_as_float(rr[0]),__uint_as_float(rr[1]));
}
__device__ __forceinline__ void pv(f32x16*o,int vb,bf16x8 pa0,bf16x8 pa1,bf16x8 pa2,bf16x8 pa3){
  #pragma unroll
  for(int d0=0;d0<2;++d0){s16x4 lo[4],hi[4];
    #pragma unroll
    for(int ks=0;ks<4;++ks){
      asm volatile("ds_read_b64_tr_b16 %0,%1 offset:%c2":"=&v"(lo[ks]):"v"(vb),"i"(d0*4096+ks*1024):"memory");
      asm volatile("ds_read_b64_tr_b16 %0,%1 offset:%c2":"=&v"(hi[ks]):"v"(vb),"i"(d0*4096+ks*1024+512):"memory");}
    asm volatile("s_waitcnt lgkmcnt(0)":::"memory");SBAR();
    #define PK(k) (bf16x8){lo[k][0],lo[k][1],lo[k][2],lo[k][3],hi[k][0],hi[k][1],hi[k][2],hi[k][3]}
    o[d0]=__builtin_amdgcn_mfma_f32_32x32x16_bf16(pa0,PK(0),o[d0],0,0,0);
    o[d0]=__builtin_amdgcn_mfma_f32_32x32x16_bf16(pa1,PK(1),o[d0],0,0,0);
    o[d0]=__builtin_amdgcn_mfma_f32_32x32x16_bf16(pa2,PK(2),o[d0],0,0,0);
    o[d0]=__builtin_amdgcn_mfma_f32_32x32x16_bf16(pa3,PK(3),o[d0],0,0,0);
    #undef PK
  }
}

#ifndef ATTN_STORE16
#define ATTN_STORE16(p,v) (*(u32x4*)(p)=(v))
#endif
template<int THRL> __device__ __forceinline__ void attn_unit(int b,int h,int qb,int jt0,const bf16*Q,const bf16*__restrict__ K,const bf16*__restrict__ V,const float*DKbh,const float*ogh,bf16*O,char*shm,const int wid,const bool pref,const int nb,const int nh,const int nqb,const int njt0,const float*DKall){
  const int lane=pg8::pg8_lane_id(),tid=wid*64+lane,r32=lane&31,hi=lane>>5; (void)tid;
  const long rowbase=(long)b*SEQ; const int q0=qb*QB;
  const bf16*Qw=Q+(rowbase+q0+wid*QBLK)*PQ+h*D;
  const bf16*Kh=K+(rowbase+(long)jt0*KVBLK)*PQ+h*D,*Vh=V+(rowbase+(long)jt0*KVBLK)*PQ+h*D; const float*Dh=DKbh+(long)jt0*KVBLK;
  const unsigned lds0=(unsigned)(uintptr_t)shm;
  float*wsf=(float*)(shm+LDS_WS)+wid*64;
  const unsigned koff=(unsigned)(lane*PQ+wid*8)*2u;
  const unsigned voff=(unsigned)((16*(wid&3)+(lane>>2))*PQ+(wid>>2)*32+(lane&3)*8)*2u, doff=(unsigned)lane*4u;
  const unsigned kdst=lds0+LDS_K+wid*1024, vdst=lds0+LDS_V+wid*1024, ddst=lds0+LDS_DK+wid*(NSLOT*256);
  #define DMA_K(t,slot) glds16s(Kh+(long)(t)*KVBLK*PQ,koff,(unsigned)__builtin_amdgcn_readfirstlane(kdst+(slot)))
  #define DMA_V(t,slot) glds16s(Vh+(long)(t)*KVBLK*PQ,voff,(unsigned)__builtin_amdgcn_readfirstlane(vdst+(slot)))
  #define DMA_D(t,slot) glds4s(Dh+(long)(t)*KVBLK,doff,(unsigned)__builtin_amdgcn_readfirstlane(ddst+((slot)>>5)))
  const int vb0=(int)(lds0+LDS_V)+((lane>>4)&1)*32+(lane&3)*8+(4*hi+((lane&15)>>2))*64;
  const char*Kbase=shm+LDS_K; bf16x8 kf[8];
  const lds_cptr shm3=(lds_cptr)shm; const lds_cptr kp0=shm3+LDS_K+hi*1024+r32*16; const lds_cptr vp0=shm3+LDS_V+((lane>>4)&1)*32+(lane&3)*8+(4*hi+((lane&15)>>2))*64;
  const lds_cptr dp0=shm3+LDS_DK+wid*(NSLOT*256)+hi*16;
  const int NT=(q0+QB)/KVBLK-jt0;
  if(!pref){DMA_K(0,0);DMA_D(0,0);DMA_V(0,0);DMA_K(1,SLOTB);}
  bf16x8 qr[4];
  if(!pref){
    #pragma unroll
    for(int d0=0;d0<4;++d0)qr[d0]=*reinterpret_cast<const bf16x8*>(&Qw[(long)r32*PQ+d0*16+hi*8]);
  }
  float mhat=0.f,l_reg=0.f;f32x16 o[2];o[0]=f32x16{};o[1]=f32x16{};const f32x16 zz=f32x16{};
  typedef float f32x4_t __attribute__((ext_vector_type(4)));
  #define BIAS(P0,P1,sl,MH) do{ const lds_cptr dq_=dp0+((sl)>>5); _Pragma("unroll") for(int g_=0;g_<4;++g_){ \
      { const f32x4_t d_=*(const __attribute__((address_space(3))) f32x4_t*)(dq_+32*g_); _Pragma("unroll") for(int j_=0;j_<4;++j_) P0[4*g_+j_]=(P0[4*g_+j_]-(MH))-d_[j_]; } asm volatile("":::"memory"); \
      { const f32x4_t d_=*(const __attribute__((address_space(3))) f32x4_t*)(dq_+32*g_+128); _Pragma("unroll") for(int j_=0;j_<4;++j_) P1[4*g_+j_]=(P1[4*g_+j_]-(MH))-d_[j_]; } asm volatile("":::"memory"); } }while(0)
  const int qrel=wid*QBLK+r32;
  #define CMASK(P0,P1,t) do{int jb_=(t)-(NT-4); if(jb_>=0)cmask(P0,P1,jb_,qrel,hi);}while(0)
  bool resc=false;
  #define START(P0,P1) do{ const float rm=rowmax(P0,P1); resc=false; \
    { const float dl=rm; mhat=fadd_s(mhat,dl); \
      _Pragma("unroll") for(int r=0;r<16;++r){P0[r]=fsub_s(P0[r],dl);P1[r]=fsub_s(P1[r],dl);} } \
    _Pragma("unroll") for(int r=0;r<16;++r)P0[r]=__builtin_amdgcn_exp2f(P0[r]); }while(0)
  #define RESC() do{ if(resc){ asm volatile("s_waitcnt lgkmcnt(0)":::"memory"); \
      _Pragma("unroll") for(int d_=0;d_<2;++d_) _Pragma("unroll") for(int r=0;r<16;++r)o[d_][r]*=wsf[crow(r,hi)]; } }while(0)
  f32x16 pA0,pA1,pB0,pB1;
  int sl_prev=0,sl_cur=0,sl_next=SLOTB;
  #define ROT() do{sl_prev=sl_cur;sl_cur=sl_next;sl_next=(sl_next==(NSLOT-1)*SLOTB)?0:sl_next+SLOTB;}while(0)
  DMA_K(2,2*SLOTB);DMA_D(1,SLOTB);
  WAIT_BAR(4);
  if(pref){
    #pragma unroll
    for(int d0=0;d0<4;++d0)qr[d0]=*(const __attribute__((address_space(3))) bf16x8*)(shm3+LDS_QPF+wid*4096+d0*1024+lane*16);
  }
  qkt(pA0,pA1,Kbase,qr,r32,hi);asm volatile("s_nop 15\n\ts_nop 7":"+v"(pA0),"+v"(pA1));BIAS(pA0,pA1,0,0.f);CMASK(pA0,pA1,0);
  START(pA0,pA1);
  _Pragma("unroll") for(int r=0;r<16;++r)pA1[r]=__builtin_amdgcn_exp2f(pA1[r]);
  WAIT_BAR(0);
  DMA_K(3,0);DMA_V(1,SLOTB);DMA_D(2,2*SLOTB);
  ROT();
  kload8(kf,kp0+sl_cur);
  WAIT_BAR(3);
  s16x4 vlo[8],vhi[8]; u32x4 pw0,pw1,pw2,pw3;
  #define PKW(P,B) cvtpk_s(P[B],P[B+1])
  #define PAF(k) __builtin_bit_cast(bf16x8,pw##k)
  #define VFR(i) (bf16x8){vlo[i][0],vlo[i][1],vlo[i][2],vlo[i][3],vhi[i][0],vhi[i][1],vhi[i][2],vhi[i][3]}
  #define PIN(x) asm volatile("":"+v"(x))
  #define MX3(a,b,c) __builtin_fmaxf(__builtin_fmaxf((a),(b)),(c))
  #define GAPA(MF,A0,A1,A2,A3,W0,W1,PW) do{ MF; sacc+=A0; sacc+=A1; sacc+=A2; sacc+=A3; PIN(sacc); W0; W1; PIN(PW); SBAR(); }while(0)
  #define EX(v) __builtin_amdgcn_exp2f(v)
  #define GAPB(MF,X,B) do{ MF; X[B]=EX(X[B]); X[B+1]=EX(X[B+1]); X[B+2]=EX(X[B+2]); X[B+3]=EX(X[B+3]); PIN(X); SBAR(); }while(0)
  #define VRD(i) do{ vlo[i]=vtr(vp_+(((i)>>2)*4096+((i)&3)*1024)); vhi[i]=vtr(vp_+(((i)>>2)*4096+((i)&3)*1024+512)); }while(0)
  #define KRD(G,j) do{ if(G){ kload2(kf,kp0+sl_next,j); SBAR(); } }while(0)
  #define STEP(C0,C1,P0,P1,t,GK,GV,GL,GD) do{ SBAR(); \
    const lds_cptr vp_=vp0+sl_prev; \
    VRD(0); SBAR(); float sacc=(P0[0]+P0[1]); \
    GAPA(C0=__builtin_amdgcn_mfma_f32_32x32x16_bf16(kf[0],qr[0],zz,0,0,0), P0[2],P0[3],P0[4],P0[5],     pw0[0]=PKW(P0,0), pw0[1]=PKW(P0,2), pw0); \
    VRD(4); SBAR(); GAPA(C1=__builtin_amdgcn_mfma_f32_32x32x16_bf16(kf[1],qr[0],zz,0,0,0), P0[6],P0[7],P0[8],P0[9],     pw0[2]=PKW(P0,4), pw0[3]=PKW(P0,6), pw0); \
    VRD(1); SBAR(); GAPA(C0=__builtin_amdgcn_mfma_f32_32x32x16_bf16(kf[2],qr[1],C0,0,0,0),   P0[10],P0[11],P0[12],P0[13], pw1[0]=PKW(P0,8), pw1[1]=PKW(P0,10), pw1); \
    VRD(5); SBAR(); GAPA(C1=__builtin_amdgcn_mfma_f32_32x32x16_bf16(kf[3],qr[1],C1,0,0,0),   P0[14],P0[15],P1[0],P1[1],   pw1[2]=PKW(P0,12),pw1[3]=PKW(P0,14), pw1); \
    VRD(2); SBAR(); GAPA(C0=__builtin_amdgcn_mfma_f32_32x32x16_bf16(kf[4],qr[2],C0,0,0,0),   P1[2],P1[3],P1[4],P1[5],     pw2[0]=PKW(P1,0), pw2[1]=PKW(P1,2), pw2); \
    VRD(6); SBAR(); GAPA(C1=__builtin_amdgcn_mfma_f32_32x32x16_bf16(kf[5],qr[2],C1,0,0,0),   P1[6],P1[7],P1[8],P1[9],     pw2[2]=PKW(P1,4), pw2[3]=PKW(P1,6), pw2); \
    VRD(3); SBAR(); GAPA(C0=__builtin_amdgcn_mfma_f32_32x32x16_bf16(kf[6],qr[3],C0,0,0,0),   P1[10],P1[11],P1[12],P1[13], pw3[0]=PKW(P1,8), pw3[1]=PKW(P1,10), pw3); \
    VRD(7); SBAR(); GAPA(C1=__builtin_amdgcn_mfma_f32_32x32x16_bf16(kf[7],qr[3],C1,0,0,0),   P1[14],P1[15],0.f,0.f,       pw3[2]=PKW(P1,12),pw3[3]=PKW(P1,14), pw3); \
    l_reg+=sacc; \
    if(GK){DMA_K((t)+3,sl_cur);} if(GV){DMA_V((t)+1,sl_next);} if(GD){DMA_D((t)+2,sl_prev);} \
    BIAS(C0,C1,sl_cur,mhat); \
    CMASK(C0,C1,t); \
    { float a=MX3(C0[0],C0[1],C1[0]),b=MX3(C0[2],C0[3],C1[1]); a=MX3(a,C1[2],C1[3]); \
      _Pragma("unroll") for(int r=4;r<16;r+=4){a=MX3(a,C0[r],C0[r+1]);b=MX3(b,C0[r+2],C0[r+3]);a=MX3(a,C1[r],C1[r+1]);b=MX3(b,C1[r+2],C1[r+3]);} \
      float rm=__builtin_fmaxf(a,b); { auto rr=__builtin_amdgcn_permlane32_swap(__float_as_uint(rm),__float_as_uint(rm),false,false); rm=__builtin_fmaxf(__uint_as_float(rr[0]),__uint_as_float(rr[1])); } \
      resc=false; \
      if(__builtin_expect(__any(rm>(float)THRL),0)){ const float dl=__builtin_fmaxf(rm,0.f); mhat+=dl; \
        _Pragma("unroll") for(int r=0;r<16;++r){C0[r]-=dl;C1[r]-=dl;} \
        const float f=__builtin_amdgcn_exp2f(-dl); l_reg*=f; if(hi==0)wsf[r32]=f; resc=true; } } \
    SBAR(); \
    GAPB(o[0]=__builtin_amdgcn_mfma_f32_32x32x16_bf16(PAF(0),VFR(0),o[0],0,0,0), C0,0); \
    GAPB(o[1]=__builtin_amdgcn_mfma_f32_32x32x16_bf16(PAF(0),VFR(4),o[1],0,0,0), C0,4); \
    KRD(GL,0); GAPB(o[0]=__builtin_amdgcn_mfma_f32_32x32x16_bf16(PAF(1),VFR(1),o[0],0,0,0), C0,8); \
    KRD(GL,1); GAPB(o[1]=__builtin_amdgcn_mfma_f32_32x32x16_bf16(PAF(1),VFR(5),o[1],0,0,0), C0,12); \
    KRD(GL,2); GAPB(o[0]=__builtin_amdgcn_mfma_f32_32x32x16_bf16(PAF(2),VFR(2),o[0],0,0,0), C1,0); \
    KRD(GL,3); GAPB(o[1]=__builtin_amdgcn_mfma_f32_32x32x16_bf16(PAF(2),VFR(6),o[1],0,0,0), C1,4); \
    GAPB(o[0]=__builtin_amdgcn_mfma_f32_32x32x16_bf16(PAF(3),VFR(3),o[0],0,0,0), C1,8); \
    GAPB(o[1]=__builtin_amdgcn_mfma_f32_32x32x16_bf16(PAF(3),VFR(7),o[1],0,0,0), C1,12); \
    }while(0)
  int t=1;
  #undef CMASK
  #define CMASK(P0,P1,t) do{}while(0)
  for(;t+5<NT;t+=2){
    STEP(pB0,pB1,pA0,pA1,t,true,true,true,true);     WAIT_BAR(3); RESC(); ROT();
    STEP(pA0,pA1,pB0,pB1,t+1,true,true,true,true);   WAIT_BAR(3); RESC(); ROT();
  }
  #undef CMASK
  #define CMASK(P0,P1,t) do{int jb_=(t)-(NT-4); if(jb_>=0)cmask(P0,P1,jb_,qrel,hi);}while(0)
  #define ENDW(tt) do{ if((tt)+3<NT){WAIT_BAR(3);} else if((tt)+2<NT){WAIT_BAR(2);} else {WAIT_BAR(0);} }while(0)
  for(;t+1<NT;t+=2){
    STEP(pB0,pB1,pA0,pA1,t,(t+3<NT),(t+1<NT),(t+1<NT),(t+2<NT));       ENDW(t);   RESC(); ROT();
    STEP(pA0,pA1,pB0,pB1,t+1,(t+4<NT),(t+2<NT),(t+2<NT),(t+3<NT));     ENDW(t+1); RESC(); ROT();
  }
  STEP(pB0,pB1,pA0,pA1,NT-1,false,false,false,false); RESC();
  { float sacc=pB0[0]+pB0[1]; _Pragma("unroll") for(int r=2;r<16;++r)sacc+=pB0[r]; _Pragma("unroll") for(int r=0;r<16;++r)sacc+=pB1[r]; l_reg+=sacc;
    pw0=(u32x4){PKW(pB0,0),PKW(pB0,2),PKW(pB0,4),PKW(pB0,6)};pw1=(u32x4){PKW(pB0,8),PKW(pB0,10),PKW(pB0,12),PKW(pB0,14)};pw2=(u32x4){PKW(pB1,0),PKW(pB1,2),PKW(pB1,4),PKW(pB1,6)};pw3=(u32x4){PKW(pB1,8),PKW(pB1,10),PKW(pB1,12),PKW(pB1,14)};
    SBAR(); pv(o,vb0+sl_cur,PAF(0),PAF(1),PAF(2),PAF(3)); }
  float ogv[8];
  #pragma unroll
  for(int e=0;e<8;++e)ogv[e]=ogh[(lane&7)*8+e];
  asm volatile("s_waitcnt lgkmcnt(0)\n\ts_barrier":::"memory");
  if(nqb>=0){ const long nrow=(long)nb*SEQ+(long)njt0*KVBLK; const bf16*nKh=K+nrow*PQ+nh*D,*nVh=V+nrow*PQ+nh*D; const float*nDh=DKall+(long)(nb*NHEAD+nh)*SEQ+(long)njt0*KVBLK;
    glds16s(nKh,koff,(unsigned)__builtin_amdgcn_readfirstlane(kdst)); glds4s(nDh,doff,(unsigned)__builtin_amdgcn_readfirstlane(ddst)); glds16s(nVh,voff,(unsigned)__builtin_amdgcn_readfirstlane(vdst)); glds16s(nKh+(long)KVBLK*PQ,koff,(unsigned)__builtin_amdgcn_readfirstlane(kdst+SLOTB));
    const bf16*nQw=Q+((long)nb*SEQ+(long)nqb*QB+wid*QBLK)*PQ+nh*D; const unsigned qoff=(unsigned)(r32*PQ+hi*8)*2u, qdst=lds0+LDS_QPF+wid*4096;
    #pragma unroll
    for(int d0=0;d0<4;++d0)glds16s(nQw+d0*16,qoff,(unsigned)__builtin_amdgcn_readfirstlane(qdst+d0*1024)); }
  #undef PKW
  #undef PAF
  #undef VFR
  #undef PIN
  #undef MX3
  #undef GAPA
  #undef GAPB
  #undef EX
  #undef VRD
  #undef KRD
  #undef STEP
  #undef ENDW
  {auto rr=__builtin_amdgcn_permlane32_swap(__float_as_uint(l_reg),__float_as_uint(l_reg),false,false);l_reg=__uint_as_float(rr[0])+__uint_as_float(rr[1]);}
  if(hi==0)wsf[32+r32]=l_reg;asm volatile("s_waitcnt lgkmcnt(0)":::"memory");
  float rli[16];
  #pragma unroll
  for(int r=0;r<16;++r)rli[r]=__builtin_amdgcn_rcpf(wsf[32+crow(r,hi)]);
  unsigned char*Ow=(unsigned char*)O+(rowbase+q0+wid*QBLK)*PO+h*D;
  { bf16*stg=(bf16*)(shm+LDS_OST)+wid*2048;
    #pragma unroll
    for(int r=0;r<16;++r){const int orow=crow(r,hi);
      #pragma unroll
      for(int d0=0;d0<2;++d0)stg[orow*64+d0*32+r32]=__float2bfloat16(o[d0][r]*rli[r]);}
    asm volatile("s_waitcnt lgkmcnt(0)":::"memory");
    #pragma unroll
    for(int i=0;i<4;++i){const int row=i*8+(lane>>3),ch=lane&7; const u32x4 v=*(const u32x4*)(stg+row*64+ch*8);
      float x[8]={__builtin_bit_cast(float,v[0]<<16),__builtin_bit_cast(float,v[0]&0xffff0000u),__builtin_bit_cast(float,v[1]<<16),__builtin_bit_cast(float,v[1]&0xffff0000u),
                  __builtin_bit_cast(float,v[2]<<16),__builtin_bit_cast(float,v[2]&0xffff0000u),__builtin_bit_cast(float,v[3]<<16),__builtin_bit_cast(float,v[3]&0xffff0000u)};
      float ss=0.f;
      #pragma unroll
      for(int e=0;e<8;++e)ss+=x[e]*x[e];
      ss+=__shfl_xor(ss,1);ss+=__shfl_xor(ss,2);ss+=__shfl_xor(ss,4);
      const float rn=1.0f/sqrtf(ss*(1.f/64.f)+1e-6f);
      float yv[8];
      #pragma unroll
      for(int e=0;e<8;++e)yv[e]=x[e]*rn*ogv[e];
      typedef unsigned u32x2_t __attribute__((ext_vector_type(2)));
      u32x2_t w; w.x=pg8::pk4_i8y(yv[0],yv[1],yv[2],yv[3]); w.y=pg8::pk4_i8y(yv[4],yv[5],yv[6],yv[7]);
      *(u32x2_t*)(Ow+(long)row*PO+ch*8)=w;} }
  asm volatile("s_waitcnt lgkmcnt(0)":::"memory");
  #undef DMA_K
  #undef DMA_V
  #undef CMASK
  #undef START
  #undef RESC
  #undef ROT
  #undef BIAS
  #undef DMA_D
}
constexpr int ATTN_LDS_BYTES=LDS_BYTES;
struct AttnTensors { const bf16* Q; const bf16* K; const bf16* V; const float* DK; const int* JT0; const float* og; bf16* O; };
struct AttnUnit { int bh; int qb; };
struct StaticOrder {
  int vcu;
  __device__ __forceinline__ explicit StaticOrder(int grid,int block):vcu((block%8)*(grid/8)+block/8){}
  __device__ __forceinline__ bool next(int i,AttnUnit&u)const{ if(i>=4)return false; const int s=vcu&7; u.bh=vcu>>3; u.qb=(i==0)?s:(i==1)?15-s:(i==2)?16+s:31-s; return true; }
  __device__ __forceinline__ void a_ready(const AttnUnit&)const{}
  __device__ __forceinline__ void done(const AttnUnit&)const{}
};
template<class Sched,int THRL=8> __device__ __forceinline__ void attn_phase(char*lds,const AttnTensors&T,const Sched&S,const int wid){
  AttnUnit u,un; bool have=S.next(0,u),pref=false;
  for(int i=0;have;++i){ S.a_ready(u); const bool hn=S.next(i+1,un);
    const int jt0=__builtin_amdgcn_readfirstlane(__hip_atomic_load(T.JT0+u.bh*NQB+u.qb,__ATOMIC_RELAXED,__HIP_MEMORY_SCOPE_AGENT));
    int njt0=0; if(hn)njt0=__builtin_amdgcn_readfirstlane(__hip_atomic_load(T.JT0+un.bh*NQB+un.qb,__ATOMIC_RELAXED,__HIP_MEMORY_SCOPE_AGENT));
    attn_unit<THRL>(u.bh/NHEAD,u.bh%NHEAD,u.qb,jt0,T.Q,T.K,T.V,T.DK+(long)u.bh*SEQ,T.og+(u.bh%NHEAD)*D,T.O,lds,wid,pref,hn?un.bh/NHEAD:0,hn?un.bh%NHEAD:0,hn?un.qb:-1,njt0,T.DK); S.done(u);
    pref=hn; u=un; have=hn; }
}
#undef SBAR
#undef WAIT_BAR
}
struct Args { const float* in[19]; float* out; unsigned char* ws; int ph_lo, ph_hi; };
typedef const __attribute__((address_space(4))) Args* KArgs;
struct Ctx { LAS unsigned char* lds; int tid, lane, wave, vcu, G, gw, NGW; };

__device__ __forceinline__ void tr_item(const float* W, int ldw, int k0, int c0, bf16* WT, int Kp, int r0, LAS float* scr, int lane) {
#pragma unroll
    for (int i = 0; i < 32; ++i) { const int kk = 2 * i + (lane >> 5); scr[kk * 33 + (lane & 31)] = W[(size_t)(k0 + kk) * ldw + c0 + (lane & 31)]; }
    LDS_WAIT(); asm volatile("" ::: "memory");
    const int c = lane & 7;
#pragma unroll
    for (int j = 0; j < 4; ++j) { const int n = (lane >> 3) + 8 * j; const LAS float* s = scr + (8 * c) * 33 + n;
        v4u o; o.x = pk2(s[0 * 33], s[1 * 33]); o.y = pk2(s[2 * 33], s[3 * 33]); o.z = pk2(s[4 * 33], s[5 * 33]); o.w = pk2(s[6 * 33], s[7 * 33]);
        *(GAS v4u*)(WT + (size_t)(r0 + n) * Kp + k0 + 8 * c) = o; }
    LDS_WAIT(); asm volatile("" ::: "memory");
}
__device__ __forceinline__ int gu_row(int f, int up) { return 256 * (f >> 7) + (up ? 128 : 0) + (f & 127); }
__device__ __forceinline__ void conv_finish(const unsigned (&d)[16], unsigned char* rowp, int p) {
    unsigned o[16];
#pragma unroll
    for (int m = 0; m < 8; ++m) {
        const unsigned mine = p ? d[8 + m] : d[m], send = p ? d[m] : d[8 + m];
        const unsigned got = (unsigned)__shfl_xor((int)send, 32);
        const unsigned E = p ? got : mine, O = p ? mine : got;
        o[2 * m] = __builtin_amdgcn_perm(O, E, 0x05010400u); o[2 * m + 1] = __builtin_amdgcn_perm(O, E, 0x07030602u);
    }
#pragma unroll
    for (int j = 0; j < 4; ++j) *(GAS v4u*)(rowp + 16 * j) = (v4u){o[4 * j], o[4 * j + 1], o[4 * j + 2], o[4 * j + 3]};
}
__device__ __forceinline__ void slab_i8(const Ctx& C, const float* W, int ldw, int c0, signed char* WT, int r0, float* sb, LAS float* cm) {
    const int n = C.lane & 31, p = C.lane >> 5;
    const float* src = W + (size_t)(128 * C.wave) * ldw + c0 + (p * ldw + n);
    float v[64];
#pragma unroll
    for (int i = 0; i < 64; ++i) v[i] = src[(size_t)(2 * i) * ldw];
    float mx = 0.f;
#pragma unroll
    for (int i = 0; i < 64; ++i) mx = fmaxf(mx, fabsf(v[i]));
    mx = fmaxf(mx, __shfl_xor(mx, 32));
    if (p == 0) cm[C.wave * 32 + n] = mx;
    __syncthreads();
    float m = cm[n];
#pragma unroll
    for (int w = 1; w < 8; ++w) m = fmaxf(m, cm[w * 32 + n]);
    const float inv = m > 0.f ? 127.f / m : 0.f;
    if (C.wave == 0 && p == 0) sb[r0 + n] = m > 0.f ? m * (1.f / 127.f) : 1.f;
    unsigned d[16];
#pragma unroll
    for (int q = 0; q < 16; ++q) {
        const unsigned t0 = __float_as_uint(fmaf(v[4 * q], inv, 12582912.f)), t1 = __float_as_uint(fmaf(v[4 * q + 1], inv, 12582912.f)), t2 = __float_as_uint(fmaf(v[4 * q + 2], inv, 12582912.f)), t3 = __float_as_uint(fmaf(v[4 * q + 3], inv, 12582912.f));
        d[q] = __builtin_amdgcn_perm(t1, t0, 0x0c0c0400u) | __builtin_amdgcn_perm(t3, t2, 0x04000c0cu); }
    conv_finish(d, (unsigned char*)WT + (size_t)(r0 + n) * DM + 128 * C.wave + 64 * p, p);
}
__device__ __forceinline__ void block_f8(const float* W, int ldw, int k0, int c0, unsigned char* WT, int Kp, int r0, float sc, int lane) {
    const int n = lane & 31, p = lane >> 5;
    const float* src = W + (size_t)k0 * ldw + c0 + (p * ldw + n);
    float v[64];
#pragma unroll
    for (int i = 0; i < 64; ++i) v[i] = src[(size_t)(2 * i) * ldw];
    unsigned d[16];
#pragma unroll
    for (int q = 0; q < 16; ++q) d[q] = pg8::pk4_fp8(v[4 * q] * sc, v[4 * q + 1] * sc, v[4 * q + 2] * sc, v[4 * q + 3] * sc);
    conv_finish(d, WT + (size_t)(r0 + n) * Kp + k0 + 64 * p, p);
}
struct F8Blk { const float* W; unsigned char* WT; int k0, c0; };
__device__ __forceinline__ void block_f8_x2(const F8Blk a, const F8Blk b, float sc, int lane) {
    const int n = lane & 31, p = lane >> 5;
    const float* sa_ = a.W + (size_t)a.k0 * DM + a.c0 + (p * DM + n); const float* sb_ = b.W + (size_t)b.k0 * DM + b.c0 + (p * DM + n);
    float va[64], vb[64];
#pragma unroll
    for (int i = 0; i < 64; ++i) va[i] = sa_[(size_t)(2 * i) * DM];
#pragma unroll
    for (int i = 0; i < 64; ++i) vb[i] = sb_[(size_t)(2 * i) * DM];
    unsigned d[16];
#pragma unroll
    for (int q = 0; q < 16; ++q) d[q] = pg8::pk4_fp8(va[4 * q] * sc, va[4 * q + 1] * sc, va[4 * q + 2] * sc, va[4 * q + 3] * sc);
    conv_finish(d, a.WT + (size_t)(a.c0 + n) * FF + a.k0 + 64 * p, p);
#pragma unroll
    for (int q = 0; q < 16; ++q) d[q] = pg8::pk4_fp8(vb[4 * q] * sc, vb[4 * q + 1] * sc, vb[4 * q + 2] * sc, vb[4 * q + 3] * sc);
    conv_finish(d, b.WT + (size_t)(b.c0 + n) * FF + b.k0 + 64 * p, p);
}
constexpr int PI_IN0 = 0, PI_OUT = 104, PI_FGU = 232, PI_FD = 456, PI_IN1 = 568, PI_MOE = 672, PI_END = 672 + 8 * 336;
__device__ __forceinline__ void prep_item(const Ctx& C, KArgs ka, unsigned char* ws, int it, int& par) {
    LAS float* cm = (LAS float*)(C.lds + 126976) + (par & 1) * 256;
    if (it < PI_OUT || (it >= PI_IN1 && it < PI_MOE)) { const int l = it >= PI_IN1, nb = it - (l ? PI_IN1 : PI_IN0), n0 = 32 * nb;
        const int c0 = n0 < 1024 ? ((n0 & ~255) + 64 * ((n0 >> 5) & 3) + 32 * ((n0 >> 7) & 1)) : (n0 < 1536 ? n0 : n0 + 8);
        slab_i8(C, ka->in[2] + (size_t)l * DM * DIN, DIN, c0, (signed char*)(ws + W_IN + l * W_IN_STRIDE), n0, (float*)(ws + T_SBIN) + l * NZ, cm); ++par; }
    else if (it < PI_FGU) { const int r = it - PI_OUT, l = r >> 5, nb = r & 31;
        if (r < 64) { slab_i8(C, ka->in[9] + (size_t)l * DM * DM, DM, 32 * nb, (signed char*)(ws + W_OUT + l * W_OUT_STRIDE), 32 * nb, (float*)(ws + T_SBO) + l * DM, cm); ++par; } }
    else if (it < PI_FD) { const int r = it - PI_FGU, up = r / 112, nb = r % 112;
        slab_i8(C, up ? ka->in[12] : ka->in[11], FF, 32 * nb, (signed char*)(ws + W_FGU), gu_row(32 * nb, up), (float*)(ws + T_SBF), cm); ++par; }
    else if (it < PI_IN1) { const int t8 = (it - PI_FD) * 8 + C.wave, kb = t8 >> 5, nb = t8 & 31;
        block_f8(ka->in[13], DM, 128 * kb, 32 * nb, ws + W_FD, FF, 32 * nb, S_WDN, C.lane); }
    else { const int r0 = it - PI_MOE, e = r0 / 336, r = r0 % 336;
        if (r < 224) { const int up = r / 112, nb = r % 112;
            slab_i8(C, (up ? ka->in[17] : ka->in[16]) + (size_t)e * DM * FF, FF, 32 * nb, (signed char*)(ws + W_MGU + e * W_MGU_STRIDE), gu_row(32 * nb, up), (float*)(ws + T_SBM) + e * 7168, cm); ++par; }
        else { const int t8 = (r - 224) * 8 + C.wave, kb = t8 >> 5, nb = t8 & 31;
            block_f8(ka->in[18] + (size_t)e * FF * DM, DM, 128 * kb, 32 * nb, ws + W_MD + e * W_MD_STRIDE, FF, 32 * nb, S_WDN, C.lane); } }
}
__device__ __forceinline__ int moe_slab_item(int s) { return PI_MOE + (s / 224) * 336 + s % 224; }
__device__ __forceinline__ int moe_down_item(int d) { return PI_MOE + (d / 112) * 336 + 224 + d % 112; }
__device__ __forceinline__ void moe_down_block(KArgs ka, unsigned char* ws, int B, int lane) { const int e = B / 896, t8 = B % 896, kb = t8 >> 5, nb = t8 & 31;
    block_f8(ka->in[18] + (size_t)e * FF * DM, DM, 128 * kb, 32 * nb, ws + W_MD + e * W_MD_STRIDE, FF, 32 * nb, S_WDN, lane); }
__device__ __forceinline__ void prep_lb(const Ctx& C, KArgs ka, unsigned char* ws) {
    if (C.vcu == 0 && C.tid < 256) { const float a = ka->in[7][C.tid], b = ka->in[7][256 + C.tid]; const float mx = fmaxf(a, b), ea = __expf(a - mx), eb = __expf(b - mx);
        float* lb = (float*)(ws + T_LB); lb[C.tid] = 0.f; lb[256 + C.tid] = eb / (ea + eb); }
}

__device__ __forceinline__ float reduce8_cols(const float (&a)[8], int lane) {
    const bool b0 = lane & 1, b1 = lane & 2, b2 = lane & 4;
    float n[4], m2[2];
#pragma unroll
    for (int i = 0; i < 4; ++i) { const float keep = b0 ? a[2 * i + 1] : a[2 * i], send = b0 ? a[2 * i] : a[2 * i + 1]; n[i] = keep + DPPF(send, 0xB1, 0xF); }
#pragma unroll
    for (int i = 0; i < 2; ++i) { const float keep = b1 ? n[2 * i + 1] : n[2 * i], send = b1 ? n[2 * i] : n[2 * i + 1]; m2[i] = keep + DPPF(send, 0x4E, 0xF); }
    const float keep = b2 ? m2[1] : m2[0], send = b2 ? m2[0] : m2[1];
    float r = keep + __builtin_bit_cast(float, __builtin_amdgcn_ds_swizzle(__builtin_bit_cast(int, send), 0x101f));
    r += DPPF(r, 0x128, 0xF);
    r += __builtin_bit_cast(float, __builtin_amdgcn_ds_swizzle(__builtin_bit_cast(int, r), 0x401f));
    r += __shfl_xor(r, 32);
    return r;
}
template <int MODE, bool I8OUT = false, bool BFIN = false>
__device__ __forceinline__ void norm_phase(const Ctx& C, const void* xin_, const float* gain, bf16* XN, float* sa, const float* wsrc, int wld, int wc0, const float* bias, float* lsig, int* tope, float* topw, int* rcnt = nullptr) {
    LAS float* wl = (LAS float*)C.lds;
    if (MODE != 1) {
        for (int i = C.tid; i < 8 * 1024; i += NWAVES * 64) { const int k = i >> 3, c = i & 7; wl[c * 1024 + k] = wsrc[(size_t)k * wld + wc0 + c]; }
        __syncthreads();
    }
    f32x4 g[4];
#pragma unroll
    for (int j = 0; j < 4; ++j) g[j] = *(const f32x4*)(gain + 4 * C.lane + 256 * j);
    float bias8 = 0.f; if (MODE != 1) bias8 = bias[C.lane & 7];
    typedef typename std::conditional<BFIN, v2u, f32x4>::type raw_t; constexpr size_t ESZ = BFIN ? 2 : 4;
    const unsigned char* xin = (const unsigned char*)xin_;
    constexpr int NB = 1;
    raw_t nv[NB][4];
#pragma unroll
    for (int r = 0; r < NB; ++r) { const int mr = C.gw + r * C.NGW < M ? C.gw + r * C.NGW : C.gw; const GAS raw_t* xr = (const GAS raw_t*)(xin + (size_t)mr * DM * ESZ) + C.lane;
#pragma unroll
      for (int j = 0; j < 4; ++j) nv[r][j] = xr[64 * j]; }
    for (int mb = C.gw; mb < M; mb += NB * C.NGW) {
      raw_t cur[NB][4];
#pragma unroll
      for (int r = 0; r < NB; ++r)
#pragma unroll
        for (int j = 0; j < 4; ++j) cur[r][j] = nv[r][j];
#pragma unroll
      for (int r = 0; r < NB; ++r) { const int mn = mb + (NB + r) * C.NGW; const GAS raw_t* xr = (const GAS raw_t*)(xin + (size_t)(mn < M ? mn : mb) * DM * ESZ) + C.lane;
#pragma unroll
        for (int j = 0; j < 4; ++j) nv[r][j] = xr[64 * j]; }
#pragma unroll
      for (int r = 0; r < NB; ++r) { const int m = mb + r * C.NGW; if (m >= M) break;
        f32x4 v[4]; f32x4 s4 = {0.f, 0.f, 0.f, 0.f};
#pragma unroll
        for (int j = 0; j < 4; ++j) { if constexpr (BFIN) { const v2u q = __builtin_bit_cast(v2u, cur[r][j]); v[j] = (f32x4){bflo(q.x), bfhi(q.x), bflo(q.y), bfhi(q.y)}; } else v[j] = __builtin_bit_cast(f32x4, cur[r][j]); }
#pragma unroll
        for (int j = 0; j < 4; ++j) s4 = __builtin_elementwise_fma(v[j], v[j], s4);
        const float rstd = 1.0f / sqrtf(wave_sum((s4.x + s4.y) + (s4.z + s4.w)) * (1.f / DM) + EPS);
#pragma unroll
        for (int j = 0; j < 4; ++j) v[j] = I8OUT ? v[j] * g[j] : v[j] * rstd * g[j];
        if (I8OUT) {
            float mx = 0.f;
#pragma unroll
            for (int j = 0; j < 4; ++j) mx = fmaxf(fmaxf(mx, fmaxf(fabsf(v[j].x), fabsf(v[j].y))), fmaxf(fabsf(v[j].z), fabsf(v[j].w)));
            mx = wave_max_nonneg(mx);
            const float iv = mx > 0.f ? 127.f / mx : 0.f;
            if (C.lane == 0) sa[m] = mx > 0.f ? mx * rstd * (1.f / 127.f) : 1.f;
            GAS unsigned* o4 = (GAS unsigned*)((unsigned char*)XN + (size_t)m * DM) + C.lane;
#pragma unroll
            for (int j = 0; j < 4; ++j) { const unsigned t0 = __float_as_uint(fmaf(v[j].x, iv, 12582912.f)), t1 = __float_as_uint(fmaf(v[j].y, iv, 12582912.f)), t2 = __float_as_uint(fmaf(v[j].z, iv, 12582912.f)), t3 = __float_as_uint(fmaf(v[j].w, iv, 12582912.f));
                o4[64 * j] = __builtin_amdgcn_perm(t1, t0, 0x0c0c0400u) | __builtin_amdgcn_perm(t3, t2, 0x04000c0cu); }
        } else { GAS v2u* o8 = (GAS v2u*)(XN + (size_t)m * DM) + C.lane;
#pragma unroll
            for (int j = 0; j < 4; ++j) { v2u w; w.x = pk2(v[j].x, v[j].y); w.y = pk2(v[j].z, v[j].w); o8[64 * j] = w; } }
        if (MODE != 1) {
            float a8[8];
#pragma unroll
            for (int c = 0; c < 8; ++c) { f32x4 a4 = {0.f, 0.f, 0.f, 0.f};
#pragma unroll
                for (int j = 0; j < 4; ++j) { const f32x4 w = *(const LAS f32x4*)(wl + c * 1024 + 4 * C.lane + 256 * j); a4 = __builtin_elementwise_fma(v[j], w, a4); }
                a8[c] = (a4.x + a4.y) + (a4.z + a4.w); }
            const float tot = reduce8_cols(a8, C.lane) * (I8OUT ? rstd : 1.0f);
            if (MODE == 0) {
                const float mine = tot + bias8;
                const float ls = fminf(mine, 0.f) - log1pf(__expf(-fabsf(mine)));
                if (C.lane < 8) lsig[(size_t)m * 8 + C.lane] = ls;
            } else {
                float acc[8]; { const float tb = tot + bias8;
#pragma unroll
                  for (int c = 0; c < 8; ++c) acc[c] = __builtin_bit_cast(float, __builtin_amdgcn_readlane(__builtin_bit_cast(int, tb), c)); }
                int i0 = 0; float v0 = acc[0];
#pragma unroll
                for (int c = 1; c < 8; ++c) if (acc[c] > v0) { v0 = acc[c]; i0 = c; }
                int i1 = -1; float v1 = -3.0e38f;
#pragma unroll
                for (int c = 0; c < 8; ++c) if (c != i0 && acc[c] > v1) { v1 = acc[c]; i1 = c; }
                const float e = __expf(v1 - v0), w0 = 1.0f / (1.0f + e), w1 = e * w0;
                if (C.lane == 0) { tope[2 * m] = i0; tope[2 * m + 1] = i1; topw[2 * m] = w0; topw[2 * m + 1] = w1;
                    __hip_atomic_fetch_add(rcnt + (m >> 6) * 16 + i0, 1, __ATOMIC_RELAXED, __HIP_MEMORY_SCOPE_AGENT); __hip_atomic_fetch_add(rcnt + (m >> 6) * 16 + 8 + i1, 1, __ATOMIC_RELAXED, __HIP_MEMORY_SCOPE_AGENT); }
            }
        }
      }
    }
}

__device__ __forceinline__ void cumsum_unit(const float* lsig, float* dk2, int* jt0tab, const float* gq, const float* gk, LAS float* sh, int bh, int tid) {
    const int b = bh >> 3, h = bh & 7, lane = tid & 63, wave = tid >> 6; const size_t base = ((size_t)b * SEQ + 16 * tid) * 8 + h;
    float x[16], s = 0.f;
#pragma unroll
    for (int i = 0; i < 16; ++i) { x[i] = lsig[base + (size_t)i * 8]; s += x[i]; }
    float inc = s;
#pragma unroll
    for (int o = 1; o < 64; o <<= 1) { const float t = __shfl_up(inc, o); if (lane >= o) inc += t; }
    if (lane == 63) sh[wave] = inc;
    __syncthreads();
    float run = inc - s;
    for (int w = 0; w < wave; ++w) run += sh[w];
    float* dst = dk2 + (size_t)bh * SEQ + 16 * tid;
#pragma unroll
    for (int i = 0; i < 16; ++i) { run += x[i]; x[i] = run; }
#pragma unroll
    for (int i = 0; i < 4; ++i) *(f32x4*)(dst + 4 * i) = (f32x4){x[4 * i], x[4 * i + 1], x[4 * i + 2], x[4 * i + 3]} * 1.4426950408889634f;
    if ((tid & 15) == 0) sh[16 + (tid >> 4)] = x[0];
    { float s16 = 0.f;
#pragma unroll
      for (int i = 0; i < 16; ++i) s16 += __expf(x[15] - x[i]);
      float tl = -x[15] + __logf(s16);
#pragma unroll
      for (int o = 1; o < 4; o <<= 1) { const float t2 = __shfl_xor(tl, o); tl = fmaxf(tl, t2) + __logf(1.0f + __expf(-fabsf(tl - t2))); }
      if ((tid & 3) == 3) sh[64 + (tid >> 2)] = tl; }
    float gqm = fabsf(gq[lane]), gkm = fabsf(gk[lane]);
#pragma unroll
    for (int o = 1; o < 64; o <<= 1) { gqm = fmaxf(gqm, __shfl_xor(gqm, o)); gkm = fmaxf(gkm, __shfl_xor(gkm, o)); }
    const float TH = 16.0f * gqm * gkm + 9.1f;
    __syncthreads();
    if (tid < 64) { const float a0 = sh[64 + 2 * tid], a1 = sh[64 + 2 * tid + 1];
        const float p1 = fmaxf(a0, a1) + __logf(1.0f + __expf(-fabsf(a0 - a1)));
        float inc = p1;
#pragma unroll
        for (int o = 1; o < 64; o <<= 1) { const float t = __shfl_up(inc, o); if (lane >= o) inc = fmaxf(inc, t) + __logf(1.0f + __expf(-fabsf(inc - t))); }
        const float ex = __shfl_up(inc, 1);
        sh[192 + 2 * tid] = lane == 0 ? a0 : fmaxf(ex, a0) + __logf(1.0f + __expf(-fabsf(ex - a0)));
        sh[192 + 2 * tid + 1] = inc; }
    __syncthreads();
    if (tid < 32) { const int qb = tid; const float Di0 = sh[16 + qb]; int lo = 0, hi = 4 * qb;
        const float Pq = qb > 0 ? sh[192 + 4 * qb - 1] : -Di0, mref = fmaxf(Pq, -Di0);
        while (lo < hi) { const int mid = (lo + hi) >> 1; const float A = sh[192 + mid];
            const float kept = mref + __logf(fmaxf(__expf(Pq - mref) - __expf(A - mref), 0.f) + __expf(-Di0 - mref));
            if (A - kept >= -TH) hi = mid; else lo = mid + 1; }
        jt0tab[bh * 32 + qb] = lo & ~1; }
}

__device__ __forceinline__ float sum8_dpp(float v) {
    v += __builtin_bit_cast(float, __builtin_amdgcn_update_dpp(0, __builtin_bit_cast(int, v), 0xB1, 0xF, 0xF, false));
    v += __builtin_bit_cast(float, __builtin_amdgcn_update_dpp(0, __builtin_bit_cast(int, v), 0x4E, 0xF, 0xF, false));
    v += __builtin_bit_cast(float, __builtin_amdgcn_update_dpp(0, __builtin_bit_cast(int, v), 0x141, 0xF, 0xF, false));
    return v; }
__device__ __forceinline__ float wave_scan_incl(float x) {
    x += DPPF(x, 0x111, 0xF); x += DPPF(x, 0x112, 0xF); x += DPPF(x, 0x114, 0xF); x += DPPF(x, 0x118, 0xF);
    x += DPPF(x, 0x142, 0xA); x += DPPF(x, 0x143, 0xC); return x; }
__device__ __forceinline__ float lane_read(float x, int l) { return __builtin_bit_cast(float, __builtin_amdgcn_readlane(__builtin_bit_cast(int, x), l)); }
__device__ __forceinline__ void hgrn_h1(const Ctx& C, const bf16* HG, const float* lbl, bf16* U, float* dch) {
    typedef short bf16x8_t __attribute__((ext_vector_type(8))); typedef float f32x16_t __attribute__((ext_vector_type(16)));
    LAS unsigned short* VTb = (LAS unsigned short*)(C.lds + 16384); LAS unsigned short* KTb = (LAS unsigned short*)(C.lds + 25600); LAS float* SC = (LAS float*)(C.lds + 34816); LAS float* LB = (LAS float*)(C.lds + 36864); constexpr int HP = 72;
    __syncthreads();
    if (C.tid < 256) LB[C.tid] = lbl[C.tid];
    const int t = C.lane, c8 = 8 * C.wave;
    v4u nf = {0u, 0u, 0u, 0u}, ni = nf;
    if (C.vcu < 2048) { const int u = C.vcu, bh = u >> 7, n = u & 127; const bf16* zp = HG + ((((size_t)((bh >> 2) * 128 + n) * 16 + (bh & 3)) * 8 + C.wave) * 64 + t) * 8; nf = *(const v4u*)(zp + 1 * 16384); ni = *(const v4u*)(zp + 2 * 16384); }
    for (int u = C.vcu; u < 2048; u += C.G) {
        const int bh = u >> 7, h = bh & 3;
        __syncthreads();
        const v4u fw = nf, iw = ni;
        if (u + C.G < 2048) { const int u2 = u + C.G, bh2 = u2 >> 7, n2 = u2 & 127; const bf16* zp = HG + ((((size_t)((bh2 >> 2) * 128 + n2) * 16 + (bh2 & 3)) * 8 + C.wave) * 64 + t) * 8; nf = *(const v4u*)(zp + 1 * 16384); ni = *(const v4u*)(zp + 2 * 16384); }
        float key[8], c[8], cr[8];
        { const f32x4 l0 = *(const LAS f32x4*)(LB + h * 64 + c8), l1 = *(const LAS f32x4*)(LB + h * 64 + c8 + 4); const float lbv[8] = {l0.x, l0.y, l0.z, l0.w, l1.x, l1.y, l1.z, l1.w};
          const float zf[8] = {bflo(fw.x), bfhi(fw.x), bflo(fw.y), bfhi(fw.y), bflo(fw.z), bfhi(fw.z), bflo(fw.w), bfhi(fw.w)};
          const unsigned short vraw[8] = {(unsigned short)(iw.x & 0xffffu), (unsigned short)(iw.x >> 16), (unsigned short)(iw.y & 0xffffu), (unsigned short)(iw.y >> 16), (unsigned short)(iw.z & 0xffffu), (unsigned short)(iw.z >> 16), (unsigned short)(iw.w & 0xffffu), (unsigned short)(iw.w >> 16)};
#pragma unroll
          for (int e = 0; e < 8; ++e) { const float lb = lbv[e]; const float f = lb + (1.0f - lb) * __builtin_amdgcn_rcpf(1.0f + __expf(-zf[e])); key[e] = 1.0f - f; c[e] = __logf(fmaxf(f, 1e-30f)); VTb[(c8 + e) * HP + t] = vraw[e]; } }
#pragma unroll
        for (int e = 0; e < 8; ++e) c[e] = wave_scan_incl(c[e]);
        float c63[8];
#pragma unroll
        for (int e = 0; e < 8; ++e) { cr[e] = lane_read(c[e], 31); c63[e] = lane_read(c[e], 63); }
#pragma unroll
        for (int e = 0; e < 8; ++e) KTb[(c8 + e) * HP + t] = (unsigned short)f2bf(key[e] * __expf(fminf(fmaxf(cr[e] - c[e], -80.f), 80.f)));
        if (t == 0) { float sc[8], dc[8];
#pragma unroll
            for (int e = 0; e < 8; ++e) { sc[e] = __expf(fmaxf(c63[e] - cr[e], -80.f)); dc[e] = __expf(c63[e]); }
            *(LAS f32x4*)(SC + c8) = (f32x4){sc[0], sc[1], sc[2], sc[3]}; *(LAS f32x4*)(SC + c8 + 4) = (f32x4){sc[4], sc[5], sc[6], sc[7]};
            *(f32x4*)(dch + u * 64 + c8) = (f32x4){dc[0], dc[1], dc[2], dc[3]}; *(f32x4*)(dch + u * 64 + c8 + 4) = (f32x4){dc[4], dc[5], dc[6], dc[7]}; }
        __syncthreads();
        if (C.wave < 4) { const int vb = C.wave >> 1, kb = C.wave & 1, r32 = C.lane & 31, hi = C.lane >> 5;
            f32x16_t acc = {};
#pragma unroll
            for (int ks = 0; ks < 4; ++ks) { const bf16x8_t a = *(const LAS bf16x8_t*)(VTb + (32 * vb + r32) * HP + 16 * ks + 8 * hi), bb = *(const LAS bf16x8_t*)(KTb + (32 * kb + r32) * HP + 16 * ks + 8 * hi);
                acc = __builtin_amdgcn_mfma_f32_32x32x16_bf16(a, bb, acc, 0, 0, 0); }
            const int k = 32 * kb + r32; const float sc = SC[k];
            LAS unsigned short* stg = (LAS unsigned short*)(C.lds + 40960 + C.wave * 2560);
#pragma unroll
            for (int r = 0; r < 16; ++r) { const int vl = (r & 3) + 8 * (r >> 2) + 4 * hi; stg[vl * 40 + r32] = (unsigned short)f2bf(acc[r] * sc); }
            LDS_WAIT(); asm volatile("" ::: "memory");
#pragma unroll
            for (int j = 0; j < 2; ++j) { const int pi = C.lane + 64 * j, row = pi >> 2, q = pi & 3;
                const v4u w = *(const LAS v4u*)(stg + row * 40 + q * 8);
                *(v4u*)(U + (size_t)u * 4096 + (32 * vb + row) * 64 + 32 * kb + q * 8) = w; }
            LDS_WAIT(); asm volatile("" ::: "memory");
        }
    }
    __syncthreads();
}
__device__ __forceinline__ void hgrn_h2(const Ctx& C, bf16* U, const float* dch) {
    const int gid = C.vcu * 256 + C.tid;
    if (C.tid < 256 && gid < 16 * 4096) { const int bh = gid >> 12, vk = gid & 4095, k = vk & 63; float s = 0.f;
#pragma unroll 32
        for (int n = 0; n < 128; ++n) { const size_t idx = (size_t)bh * 128 + n; const float uu = bf2f(U[idx * 4096 + vk]), d = dch[idx * 64 + k]; U[idx * 4096 + vk] = (bf16)f2bf(s); s = d * s + uu; } }
}
__device__ __forceinline__ void hgrn_h3(const Ctx& C, const bf16* HG, const float* lbl, const bf16* U, const float* og, bf16* Y) {
    typedef short bf16x8_t __attribute__((ext_vector_type(8))); typedef short bf16x4_t __attribute__((ext_vector_type(4))); typedef float f32x16_t __attribute__((ext_vector_type(16)));
    constexpr int HP = 72, OP = 68, SETB = 36864;
    LAS float* OT = (LAS float*)(C.lds + 73728); LAS float* LB = (LAS float*)(C.lds + 91136); LAS float* OG = (LAS float*)(C.lds + 92160);
    __syncthreads();
    if (C.tid < 256) { LB[C.tid] = lbl[C.tid]; OG[C.tid] = og[768 + C.tid]; }
    const int nu = C.vcu < 2048 ? (2048 - C.vcu + C.G - 1) / C.G : 0;
    __syncthreads();
    if (C.wave >= 4) {
        const int pw = C.wave - 4, t = C.lane, c16 = 16 * pw;
        v4u nf[2], ni[2], nq[2], ns[2];
#define H3_LOAD(u_) do { const int bh_ = (u_) >> 7, n_ = (u_) & 127; const bf16* zr_ = HG + (((size_t)((bh_ >> 2) * 128 + n_) * 16 + (bh_ & 3)) * 8) * 512; \
        _Pragma("unroll") for (int w_ = 0; w_ < 2; ++w_) { const bf16* zp_ = zr_ + ((2 * pw + w_) * 64 + t) * 8; nq[w_] = *(const v4u*)(zp_); nf[w_] = *(const v4u*)(zp_ + 16384); ni[w_] = *(const v4u*)(zp_ + 32768); \
            ns[w_] = *(const v4u*)(U + (size_t)(u_) * 4096 + t * 64 + c16 + 8 * w_); } } while (0)
        if (nu > 0) H3_LOAD(C.vcu);
        for (int i = 0; i <= nu; ++i) {
            const int u = C.vcu + i * C.G, h = (u >> 7) & 3;
            LAS unsigned short* VTb = (LAS unsigned short*)(C.lds + (i & 1) * SETB); LAS unsigned short* QB = VTb + 64 * HP; LAS unsigned short* KB = QB + 64 * HP; LAS unsigned short* SB = KB + 64 * HP;
            float key[16], qs[16], c[16]; v4u sw[2];
            if (i < nu) {
                const v4u fw[2] = {nf[0], nf[1]}, iw[2] = {ni[0], ni[1]}, qw[2] = {nq[0], nq[1]}; sw[0] = ns[0]; sw[1] = ns[1];
                if (i + 1 < nu) H3_LOAD(u + C.G);
#pragma unroll
                for (int w = 0; w < 2; ++w) {
                    const f32x4 l0 = *(const LAS f32x4*)(LB + h * 64 + c16 + 8 * w), l1 = *(const LAS f32x4*)(LB + h * 64 + c16 + 8 * w + 4); const float lbv[8] = {l0.x, l0.y, l0.z, l0.w, l1.x, l1.y, l1.z, l1.w};
                    const float zf[8] = {bflo(fw[w].x), bfhi(fw[w].x), bflo(fw[w].y), bfhi(fw[w].y), bflo(fw[w].z), bfhi(fw[w].z), bflo(fw[w].w), bfhi(fw[w].w)};
                    const float qf[8] = {bflo(qw[w].x), bfhi(qw[w].x), bflo(qw[w].y), bfhi(qw[w].y), bflo(qw[w].z), bfhi(qw[w].z), bflo(qw[w].w), bfhi(qw[w].w)};
                    const unsigned short vraw[8] = {(unsigned short)(iw[w].x & 0xffffu), (unsigned short)(iw[w].x >> 16), (unsigned short)(iw[w].y & 0xffffu), (unsigned short)(iw[w].y >> 16), (unsigned short)(iw[w].z & 0xffffu), (unsigned short)(iw[w].z >> 16), (unsigned short)(iw[w].w & 0xffffu), (unsigned short)(iw[w].w >> 16)};
#pragma unroll
                    for (int e = 0; e < 8; ++e) { const float lb = lbv[e]; const float f = lb + (1.0f - lb) * __builtin_amdgcn_rcpf(1.0f + __expf(-zf[e])); key[8 * w + e] = 1.0f - f; c[8 * w + e] = __logf(fmaxf(f, 1e-30f));
                        qs[8 * w + e] = qf[e] * __builtin_amdgcn_rcpf(1.0f + __expf(-qf[e])); VTb[(c16 + 8 * w + e) * HP + t] = vraw[e]; } }
            }
            __syncthreads();
            if (i < nu) {
#pragma unroll
                for (int e = 0; e < 16; ++e) c[e] = wave_scan_incl(c[e]);
#pragma unroll
                for (int w = 0; w < 2; ++w) {
                    const float sv[8] = {bflo(sw[w].x), bfhi(sw[w].x), bflo(sw[w].y), bfhi(sw[w].y), bflo(sw[w].z), bfhi(sw[w].z), bflo(sw[w].w), bfhi(sw[w].w)};
                    float qt[8], kt[8], sp[8];
#pragma unroll
                    for (int e = 0; e < 8; ++e) { const float cr = lane_read(c[8 * w + e], 31); const float d = fminf(fmaxf(c[8 * w + e] - cr, -80.f), 80.f); qt[e] = qs[8 * w + e] * __expf(d); kt[e] = key[8 * w + e] * __expf(-d); sp[e] = sv[e] * __expf(cr); }
                    v4u x; x.x = pk2(qt[0], qt[1]); x.y = pk2(qt[2], qt[3]); x.z = pk2(qt[4], qt[5]); x.w = pk2(qt[6], qt[7]); *(LAS v4u*)(QB + t * HP + c16 + 8 * w) = x;
                    x.x = pk2(kt[0], kt[1]); x.y = pk2(kt[2], kt[3]); x.z = pk2(kt[4], kt[5]); x.w = pk2(kt[6], kt[7]); *(LAS v4u*)(KB + t * HP + c16 + 8 * w) = x;
                    x.x = pk2(sp[0], sp[1]); x.y = pk2(sp[2], sp[3]); x.z = pk2(sp[4], sp[5]); x.w = pk2(sp[6], sp[7]); *(LAS v4u*)(SB + t * HP + c16 + 8 * w) = x; }
            }
            __syncthreads();
        }
#undef H3_LOAD
    } else {
        const int te = C.tid >> 2, c16e = (C.tid & 3) * 16;
        v4u ng[2] = {{0u, 0u, 0u, 0u}, {0u, 0u, 0u, 0u}};
#define H3_LOADG(u_) do { const int bh_ = (u_) >> 7, n_ = (u_) & 127; const bf16* zg_ = HG + (((size_t)((bh_ >> 2) * 128 + n_) * 16 + (bh_ & 3)) * 8) * 512 + 3 * 16384; \
        ng[0] = *(const v4u*)(zg_ + ((2 * (C.tid & 3)) * 64 + te) * 8); ng[1] = *(const v4u*)(zg_ + ((2 * (C.tid & 3) + 1) * 64 + te) * 8); } while (0)
        if (nu > 0) H3_LOADG(C.vcu);
        for (int i = 0; i <= nu; ++i) {
            const int u = C.vcu + (i - 1) * C.G, bh = u >> 7, n = u & 127, b = bh >> 2, h = bh & 3;
            const v4u gw[2] = {ng[0], ng[1]};
            if (i >= 1 && i < nu) H3_LOADG(u + C.G);
            if (i >= 1) {
                const LAS unsigned short* VTb = (const LAS unsigned short*)(C.lds + ((i - 1) & 1) * SETB); const LAS unsigned short* QB = VTb + 64 * HP; const LAS unsigned short* KB = QB + 64 * HP; const LAS unsigned short* SB = KB + 64 * HP;
            { const int vb = C.wave >> 1, tb = C.wave & 1, r32 = C.lane & 31, hi = C.lane >> 5;
            f32x16_t o = {};
            bf16x8_t qf4[4];
#pragma unroll
            for (int ks = 0; ks < 4; ++ks) qf4[ks] = *(const LAS bf16x8_t*)(QB + (32 * tb + r32) * HP + 16 * ks + 8 * hi);
#pragma unroll
            for (int ks = 0; ks < 4; ++ks) { const bf16x8_t a = *(const LAS bf16x8_t*)(SB + (32 * vb + r32) * HP + 16 * ks + 8 * hi); o = __builtin_amdgcn_mfma_f32_32x32x16_bf16(a, qf4[ks], o, 0, 0, 0); }
            for (int sb = 0; sb <= tb; ++sb) {
                f32x16_t x = {};
#pragma unroll
                for (int ks = 0; ks < 4; ++ks) { const bf16x8_t a = *(const LAS bf16x8_t*)(KB + (32 * sb + r32) * HP + 16 * ks + 8 * hi); x = __builtin_amdgcn_mfma_f32_32x32x16_bf16(a, qf4[ks], x, 0, 0, 0); }
                if (sb == tb) {
#pragma unroll
                    for (int r = 0; r < 16; ++r) { const int srow = (r & 3) + 8 * (r >> 2) + 4 * hi; if (srow > r32) x[r] = 0.f; } }
#pragma unroll
                for (int s2 = 0; s2 < 2; ++s2) {
                    v4u pw; pw.x = pk2(x[8 * s2 + 0], x[8 * s2 + 1]); pw.y = pk2(x[8 * s2 + 2], x[8 * s2 + 3]); pw.z = pk2(x[8 * s2 + 4], x[8 * s2 + 5]); pw.w = pk2(x[8 * s2 + 6], x[8 * s2 + 7]);
                    const int s0 = 32 * sb + 16 * s2 + 4 * hi;
                    const bf16x4_t v0 = *(const LAS bf16x4_t*)(VTb + (32 * vb + r32) * HP + s0), v1 = *(const LAS bf16x4_t*)(VTb + (32 * vb + r32) * HP + s0 + 8);
                    const bf16x8_t av = {v0[0], v0[1], v0[2], v0[3], v1[0], v1[1], v1[2], v1[3]};
                    o = __builtin_amdgcn_mfma_f32_32x32x16_bf16(av, __builtin_bit_cast(bf16x8_t, pw), o, 0, 0, 0); }
            }
            LAS float* op = OT + (32 * tb + r32) * OP + 32 * vb + 4 * hi;
#pragma unroll
            for (int g4 = 0; g4 < 4; ++g4) *(LAS f32x4*)(op + 8 * g4) = (f32x4){o[4 * g4 + 0], o[4 * g4 + 1], o[4 * g4 + 2], o[4 * g4 + 3]};
        }
            }
            __syncthreads();
            if (i >= 1) {
                float ov[16], ss = 0.f;
#pragma unroll
                for (int q = 0; q < 4; ++q) { const f32x4 o4 = *(const LAS f32x4*)(OT + te * OP + c16e + 4 * q); ov[4 * q] = o4.x; ov[4 * q + 1] = o4.y; ov[4 * q + 2] = o4.z; ov[4 * q + 3] = o4.w; ss += (o4.x * o4.x + o4.y * o4.y) + (o4.z * o4.z + o4.w * o4.w); }
                ss += DPPF(ss, 0xB1, 0xF); ss += DPPF(ss, 0x4E, 0xF);
                const float r = 1.0f / sqrtf(ss * (1.f / 64.f) + EPS);
                const size_t m = (size_t)b * SEQ + n * 64 + te;
                unsigned yq[4];
#pragma unroll
                for (int w = 0; w < 2; ++w) {
                    const float gf[8] = {bflo(gw[w].x), bfhi(gw[w].x), bflo(gw[w].y), bfhi(gw[w].y), bflo(gw[w].z), bfhi(gw[w].z), bflo(gw[w].w), bfhi(gw[w].w)};
                    const f32x4 g0 = *(const LAS f32x4*)(OG + h * 64 + c16e + 8 * w), g1 = *(const LAS f32x4*)(OG + h * 64 + c16e + 8 * w + 4); const float gg[8] = {g0.x, g0.y, g0.z, g0.w, g1.x, g1.y, g1.z, g1.w};
                    float y[8];
#pragma unroll
                    for (int e = 0; e < 8; ++e) y[e] = ov[8 * w + e] * r * gg[e] * (gf[e] * __builtin_amdgcn_rcpf(1.0f + __expf(-gf[e])));
                    yq[2 * w] = pg8::pk4_i8y(y[0], y[1], y[2], y[3]); yq[2 * w + 1] = pg8::pk4_i8y(y[4], y[5], y[6], y[7]); }
                *(v4u*)((unsigned char*)Y + m * DM + 768 + h * 64 + c16e) = (v4u){yq[0], yq[1], yq[2], yq[3]};
            }
            __syncthreads();
        }
#undef H3_LOADG
    }
    __syncthreads();
}
__device__ __forceinline__ void conv_phase(const Ctx& C, const bf16* Z, const float* cw, const float* og, bf16* Y) {
    const int c0 = 4 * C.lane;
    const f32x4 w0 = *(const f32x4*)(cw + c0), w1 = *(const f32x4*)(cw + 256 + c0), w2 = *(const f32x4*)(cw + 512 + c0), gg = *(const f32x4*)(og + 512 + c0);
    for (int m0 = C.gw * 16; m0 < M; m0 += C.NGW * 16) {
        const int t0 = m0 & (SEQ - 1);
        v2u rx[16], rc[16], rb[16], hx[2], hc[2];
#pragma unroll
        for (int i = 0; i < 2; ++i) { const bf16* zp = Z + (size_t)(t0 >= 2 - i ? m0 - 2 + i : m0) * ZP + c0; hx[i] = *(const v2u*)(zp + ZCX); hc[i] = *(const v2u*)(zp + ZCC); }
#pragma unroll
        for (int i = 0; i < 16; ++i) { const bf16* zp = Z + (size_t)(m0 + i) * ZP + c0; rx[i] = *(const v2u*)(zp + ZCX); rc[i] = *(const v2u*)(zp + ZCC); rb[i] = *(const v2u*)(zp + ZCB); }
        f32x4 u2 = {0.f, 0.f, 0.f, 0.f}, u1 = u2;
        if (t0 >= 2) u2 = (f32x4){bflo(hx[0].x) * bflo(hc[0].x), bfhi(hx[0].x) * bfhi(hc[0].x), bflo(hx[0].y) * bflo(hc[0].y), bfhi(hx[0].y) * bfhi(hc[0].y)};
        if (t0 >= 1) u1 = (f32x4){bflo(hx[1].x) * bflo(hc[1].x), bfhi(hx[1].x) * bfhi(hc[1].x), bflo(hx[1].y) * bflo(hc[1].y), bfhi(hx[1].y) * bfhi(hc[1].y)};
#pragma unroll
        for (int i = 0; i < 16; ++i) { const int m = m0 + i;
            const v2u xv = rx[i], cv = rc[i], bv = rb[i];
            const f32x4 u0 = {bflo(xv.x) * bflo(cv.x), bfhi(xv.x) * bfhi(cv.x), bflo(xv.y) * bflo(cv.y), bfhi(xv.y) * bfhi(cv.y)};
            const f32x4 acc = u2 * w0 + u1 * w1 + u0 * w2;
            f32x4 y = {bflo(bv.x) * acc.x, bfhi(bv.x) * acc.y, bflo(bv.y) * acc.z, bfhi(bv.y) * acc.w};
            float ss = (y.x * y.x + y.y * y.y) + (y.z * y.z + y.w * y.w);
            ss += DPPF(ss, 0xB1, 0xF); ss += DPPF(ss, 0x4E, 0xF); ss += DPPF(ss, 0x141, 0xF); ss += DPPF(ss, 0x140, 0xF);
            const float r = 1.0f / sqrtf(ss * (1.f / 64.f) + EPS);
            y = y * r * gg;
            *(unsigned*)((unsigned char*)Y + (size_t)m * DM + 512 + c0) = pg8::pk4_i8y(y.x, y.y, y.z, y.w);
            u2 = u1; u1 = u0; }
    }
}

__device__ __forceinline__ void moe_count(const Ctx& C, unsigned char* ws) {
    int* idx = (int*)(ws + T_IDX);
    for (int i = C.vcu * (NWAVES * 64) + C.tid; i < MAXROWS; i += C.G * NWAVES * 64) idx[i] = -1;
}
__device__ __forceinline__ int moe_remap(int lin, int P0, int m0, int m1) { if (lin < P0) return lin < m0 ? lin : m0 + m1 + (lin - m0); const int pl = lin - P0; return pl < m1 ? m0 + pl : m0 + m1 + (P0 - m0) + (pl - m1); }
__device__ __forceinline__ void moe_scan(const Ctx& C, unsigned char* ws) {
    if (C.vcu != 0) return;
    LAS int* cl = (LAS int*)C.lds;
    LAS int* sh = cl + 512 * 16;
    const int* cnt = (const int*)(ws + WS_CTL + CNT_CTL_OFF); int* cbase = (int*)(ws + T_CBASE); int* pexp = (int*)(ws + T_PEXP); int* meta = (int*)(ws + T_META);
    typedef int i32x4 __attribute__((ext_vector_type(4)));
#pragma unroll
    for (int j = 0; j < 4; ++j) *(LAS i32x4*)(cl + C.tid * 16 + 4 * j) = (i32x4){ldi(cnt + C.tid * 16 + 4 * j), ldi(cnt + C.tid * 16 + 4 * j + 1), ldi(cnt + C.tid * 16 + 4 * j + 2), ldi(cnt + C.tid * 16 + 4 * j + 3)};
    __syncthreads();
#pragma unroll
    for (int cc = 0; cc < 2; ++cc) { const int c = 2 * C.wave + cc; int v[8], s = 0;
#pragma unroll
        for (int i = 0; i < 8; ++i) { v[i] = cl[(8 * C.lane + i) * 16 + c]; s += v[i]; }
        int inc = s;
#pragma unroll
        for (int o = 1; o < 64; o <<= 1) { const int t = __shfl_up(inc, o); if (C.lane >= o) inc += t; }
        int run = inc - s;
#pragma unroll
        for (int i = 0; i < 8; ++i) { cl[(8 * C.lane + i) * 16 + c] = run; run += v[i]; }
        if (C.lane == 63) sh[c] = inc; }
    __syncthreads();
    if (C.tid == 0) { int pos = 0, P0 = 0;
        for (int r = 0; r < 2; ++r) { for (int e = 0; e < 8; ++e) { sh[16 + r * 8 + e] = pos; pos += ((sh[r * 8 + e] + 255) / 256) * 256; } if (r == 0) P0 = pos / 256; }
        sh[32] = P0; sh[33] = pos / 256; sh[34] = 0; sh[35] = 0; }
    __syncthreads();
    { const int P0 = sh[32], P = sh[33], P1 = P - P0, m0 = P0 < 128 ? P0 : 128, m1 = P1 < 128 ? P1 : 128;
      if (C.tid < P) { const int lin = C.tid; int i = 0;
#pragma unroll
          for (int j = 1; j < 16; ++j) if (lin >= (sh[16 + j] >> 8)) i = j;
          pexp[moe_remap(lin, P0, m0, m1)] = i & 7;
          if (lin < P0) { if (lin >= m0) atomicOr((unsigned*)(sh + 34), 1u << (i & 7)); } else if (lin - P0 >= m1) atomicOr((unsigned*)(sh + 35), 1u << (i & 7)); }
      __syncthreads();
      if (C.tid == 0) { const int emask0 = sh[34], emask1 = sh[35], eu = emask0 | emask1;
        meta[0] = 0; meta[1] = P0; meta[2] = P; meta[3] = m0; meta[4] = m1; meta[5] = (emask0 == 0 || emask1 == 0 || (eu & (eu - 1)) == 0) ? 1 : 0; } }
    __syncthreads();
#pragma unroll
    for (int j = 0; j < 4; ++j) { i32x4 o = *(const LAS i32x4*)(cl + C.tid * 16 + 4 * j); const i32x4 st = *(const LAS i32x4*)(sh + 16 + 4 * j); o += st; *(i32x4*)(cbase + C.tid * 16 + 4 * j) = o; }
}
__device__ __forceinline__ void moe_assign(const Ctx& C, unsigned char* ws) {
    const int* tope = (const int*)(ws + T_TOPE); const float* topw = (const float*)(ws + T_TOPW); const int* cbase = (const int*)(ws + T_CBASE); const int* meta = (const int*)(ws + T_META);
    int* idx = (int*)(ws + T_IDX); float* wgt = (float*)(ws + T_WGT);
    const int P0 = ldi(meta + 1), m0 = ldi(meta + 3), m1 = ldi(meta + 4), mg = ldi(meta + 5);
    const unsigned long long below = (1ull << C.lane) - 1ull;
    for (int ck = C.gw; ck < M / 64; ck += C.NGW) {
        const int tok = ck * 64 + C.lane; int pl[2];
        const int cbv = ldi(cbase + ck * 16 + (C.lane & 15));
#pragma unroll
        for (int r = 0; r < 2; ++r) { const int er = ldi(tope + 2 * tok + r); int before = 0;
#pragma unroll
            for (int e = 0; e < 8; ++e) { const unsigned long long mk = __ballot(er == e); if (er == e) before = __popcll(mk & below); }
            pl[r] = __shfl(cbv, r * 8 + er) + before; }
        const int ph0 = (pl[0] >> 8) < m0 ? 23 : 22, ph1 = ((pl[1] >> 8) - P0) < m1 ? 25 : (mg ? 22 : 24);
#pragma unroll
        for (int r = 0; r < 2; ++r) { const int pos = moe_remap(pl[r] >> 8, P0, m0, m1) * 256 + (pl[r] & 255); const int first = r == 0 ? (ph0 < ph1) : (ph1 < ph0);
            idx[pos] = tok | (first << 30); wgt[pos] = topw[2 * tok + r]; }
    }
}
__device__ __forceinline__ void moe_gather(const Ctx& C, unsigned char* ws, int np) {
    const int* idx = (const int*)(ws + T_IDX); const unsigned char* XN2 = ws + WS_B; unsigned char* XS = ws + WS_XS; const float* sa = (const float*)(ws + T_SA); float* sas = (float*)(ws + T_SAS);
    const int nrows = np * 256; constexpr int RT = 8;
    int tok[RT];
#pragma unroll
    for (int i = 0; i < RT; ++i) tok[i] = (C.gw * RT + i < nrows) ? ldi(idx + C.gw * RT + i) : -1;
    for (int r0 = C.gw * RT; r0 < nrows; r0 += C.NGW * RT) {
        v4u a[RT]; float s[RT]; int tn[RT];
#pragma unroll
        for (int i = 0; i < RT; ++i) { a[i] = (v4u){0u, 0u, 0u, 0u}; s[i] = 0.f; if (tok[i] >= 0) { const int tk = tok[i] & 0x3fffffff; a[i] = ((const v4u*)(XN2 + (size_t)tk * DM))[C.lane]; s[i] = sa[tk]; } }
#pragma unroll
        for (int i = 0; i < RT; ++i) { const int rn = r0 + C.NGW * RT + i; tn[i] = rn < nrows ? ldi(idx + rn) : -1; }
#pragma unroll
        for (int i = 0; i < RT; ++i) if (r0 + i < nrows) { ((v4u*)(XS + (size_t)(r0 + i) * DM))[C.lane] = a[i]; if (C.lane == 0) sas[r0 + i] = s[i]; }
#pragma unroll
        for (int i = 0; i < RT; ++i) tok[i] = tn[i];
    }
}

#ifndef MK_MULTI
#define MK_MULTI 0
#endif
constexpr int NPH = 26;
#define IN(k) (lo <= (k) && (k) < hi)
#define FRESH() KArgs ka = ka0; asm volatile("" : "+s"(ka)); unsigned char* ws = ka->ws; float* out = ka->out; Ctx C; C.lds = C0.lds; C.G = C0.G; C.NGW = C0.NGW; { int w_ = C0.wave; asm volatile("" : "+s"(w_)); C.wave = w_; C.lane = pg8::pg8_lane_id(); C.tid = w_ * 64 + C.lane; int v_ = C0.vcu; asm volatile("" : "+s"(v_)); C.vcu = v_; C.gw = v_ * NWAVES + C.wave; } bf16* WA = (bf16*)(ws + WS_A); bf16* WB = (bf16*)(ws + WS_B); bf16* Z = (bf16*)(ws + WS_S); bf16* XB = (bf16*)(ws + WS_XB); (void)XB; float* lsig = (float*)(ws + T_LSIG); float* dcum = (float*)(ws + T_DCUM); (void)WA; (void)WB; (void)Z; (void)lsig; (void)dcum; (void)out
#define SEAM(k) do { if (lo <= (k) && (k) + 1 < hi) xcd_barrier(bar); } while (0)

template <int l> __device__ __forceinline__ void layer_common(const KArgs ka0, const Ctx& C0, const XcdBarrier& bar, const int lo, const int hi) {
        const int pb = 9 * l;
        if (IN(1 + pb)) {
            if (l == 0) { FRESH(); int par = 0; const int lim = C.G == 256 ? PI_FGU : PI_MOE;
                for (int it = (int)blockIdx.x; it < lim; it += C.G) prep_item(C, ka, ws, it, par); prep_lb(C, ka, ws); __syncthreads(); }
            { FRESH(); if constexpr (l == 0) norm_phase<0, true, false>(C, ka->in[0], ka->in[1] + l * DM, WA, (float*)(ws + T_SA), ka->in[2] + (size_t)l * DM * DIN, DIN, 1536, ka->in[3] + l * 8, lsig, nullptr, nullptr);
              else norm_phase<0, true, true>(C, XB, ka->in[1] + l * DM, WA, (float*)(ws + T_SA), ka->in[2] + (size_t)l * DM * DIN, DIN, 1536, ka->in[3] + l * 8, lsig, nullptr, nullptr); } }
        SEAM(1 + pb);
        if (IN(2 + pb)) { FRESH();
            pg8::Gemm g{WA, (const bf16*)(ws + W_IN + l * W_IN_STRIDE), M, NZ, DM / 2}; pg8::StaticOrder S; S.init(M, NZ, C.G, (int)blockIdx.x);
            typedef pg8::EpiStoreI8<(long)((WS_HG - WS_S) / 2)> EpiIn; EpiIn E{Z, ZP, (const float*)(ws + T_SA), (const float*)(ws + T_SBIN) + l * NZ, ka->in[4] + l * 64, ka->in[5] + l * 64};
            pg8::gemm_phase<EpiIn, pg8::StaticOrder, true, true, true>(C.lds + RING_OFF, g, S, E, C.wave);
            { const int bx = (int)blockIdx.x; if (bx >= 128 && bx < 160) cumsum_unit(lsig, (float*)(ws + T_DK2), (int*)(ws + T_JT0), ka->in[4] + l * 64, ka->in[5] + l * 64, (LAS float*)C.lds, bx - 128, C.tid); }
            if (l == 0) { const int j = (int)blockIdx.x - 128;
                if (j >= 0 && C.G == 256) { FRESH(); int par = 0; for (int r = 0; r < 2; ++r) { const int q = r * 128 + j; prep_item(C, ka, ws, q < 224 ? PI_FGU + q : PI_IN1 + q - 224, par); }
                    if (j < 72) prep_item(C, ka, ws, PI_IN1 + 32 + j, par); else prep_item(C, ka, ws, moe_slab_item(j - 72), par); } }
            else { const int j = (int)blockIdx.x - 128;
                if (j >= 0 && C.G == 256) { FRESH(); int par = 0; const int n = j < 32 ? 3 : 4, s0 = j < 32 ? 56 + 3 * j : 152 + 4 * (j - 32); for (int r = 0; r < n; ++r) prep_item(C, ka, ws, moe_slab_item(s0 + r), par); } }
        }
        SEAM(2 + pb);
        if (IN(3 + pb)) { FRESH();
            { conv_phase(C, Z, ka->in[6] + l * 768, ka->in[8] + l * DM, WA); }
            { FRESH(); hgrn_h1(C, (const bf16*)(ws + WS_HG), (const float*)(ws + T_LB) + l * 256, (bf16*)(ws + WS_B), (float*)(ws + WS_B + 32 * MiB)); } }
        SEAM(3 + pb);
        if (IN(4 + pb)) { FRESH(); hgrn_h2(C, (bf16*)(ws + WS_B), (const float*)(ws + WS_B + 32 * MiB));
            if (C.wave >= 4 && C.G == 256) { F8Blk bl[2];
#pragma unroll
                for (int jj = 0; jj < 2; ++jj) { const int s = jj * 1024 + C.vcu * 4 + (C.wave - 4);
                    if (l == 0 && s < 896) bl[jj] = F8Blk{ka->in[13], ws + W_FD, 128 * (s >> 5), 32 * (s & 31)};
                    else { const int B = l == 0 ? s - 896 : 1152 + s, e = B / 896, t8 = B % 896; bl[jj] = F8Blk{ka->in[18] + (size_t)e * FF * DM, ws + W_MD + e * W_MD_STRIDE, 128 * (t8 >> 5), 32 * (t8 & 31)}; } }
                block_f8_x2(bl[0], bl[1], S_WDN, C.lane); } }
        SEAM(4 + pb);
        if (IN(5 + pb)) { FRESH();
            { hgrn_h3(C, (const bf16*)(ws + WS_HG), (const float*)(ws + T_LB) + l * 256, (const bf16*)(ws + WS_B), ka->in[8] + l * DM, WA); }
            { FRESH(); __syncthreads();
              const attn_body::AttnTensors AT{(const attn_body::bf16*)(Z + ZQ), (const attn_body::bf16*)(Z + ZK), (const attn_body::bf16*)(Z + ZV), (const float*)(ws + T_DK2), (const int*)(ws + T_JT0), ka->in[8] + l * DM, (attn_body::bf16*)WA};
              const attn_body::StaticOrder S((int)C.G, (int)blockIdx.x);
              attn_body::attn_phase<attn_body::StaticOrder, 20>((char*)C.lds + RING_OFF, AT, S, C.wave); }
        }
        SEAM(5 + pb);
        if (IN(6 + pb)) { FRESH();
            pg8::Gemm g{WA, (const bf16*)(ws + W_OUT + l * W_OUT_STRIDE), M, DM, DM / 2}; pg8::StaticOrder S; S.init(M, DM, C.G, (int)blockIdx.x);
            if constexpr (l == 0) { pg8::EpiResidI8<false> E{ka->in[0], (pg8::bf16_t*)XB, DM, 1.0f / pg8::S_Y, (const float*)(ws + T_SBO) + l * DM}; pg8::gemm_phase<pg8::EpiResidI8<false>, pg8::StaticOrder, true, true, true>(C.lds + RING_OFF, g, S, E, C.wave); }
            else { pg8::EpiResidI8<true> E{XB, (pg8::bf16_t*)XB, DM, 1.0f / pg8::S_Y, (const float*)(ws + T_SBO) + l * DM}; pg8::gemm_phase<pg8::EpiResidI8<true>, pg8::StaticOrder, true, true, true>(C.lds + RING_OFF, g, S, E, C.wave); }
        }
        SEAM(6 + pb);
        if (IN(7 + pb)) { FRESH();
            if (l == 0) norm_phase<1, true, true>(C, XB, ka->in[10] + l * DM, WB, (float*)(ws + T_SA), nullptr, 0, 0, nullptr, nullptr, nullptr, nullptr);
            else norm_phase<2, true, true>(C, XB, ka->in[10] + l * DM, WB, (float*)(ws + T_SA), ka->in[14], 8, 0, ka->in[15], nullptr, (int*)(ws + T_TOPE), (float*)(ws + T_TOPW), (int*)(ws + WS_CTL + CNT_CTL_OFF));
        }
        if (l == 0) SEAM(7 + pb);
}
__device__ __forceinline__ void ffn_dense(const KArgs ka0, const Ctx& C0, const XcdBarrier& bar, const int lo, const int hi) {
            if (IN(8)) { FRESH();
                pg8::Gemm g{(const bf16*)(ws + WS_B), (const bf16*)(ws + W_FGU), M, 2 * FF, DM / 2}; pg8::StaticOrder S; S.init(M, 2 * FF, C.G, (int)blockIdx.x);
                pg8::EpiSwiGLUi8 E{ws + WS_HD, FF, (const float*)(ws + T_SA), (const float*)(ws + T_SBF), 0, S_HID};
                pg8::gemm_phase<pg8::EpiSwiGLUi8, pg8::StaticOrder, true, true, true>(C.lds + RING_OFF, g, S, E, C.wave);
            }
            SEAM(8);
            if (IN(9)) { FRESH();
                pg8::Gemm g{(const bf16*)(ws + WS_HD), (const bf16*)(ws + W_FD), M, DM, FF / 2}; pg8::StaticOrder S; S.init(M, DM, C.G, (int)blockIdx.x);
                pg8::EpiResidB<true, true> E{XB, (pg8::bf16_t*)XB, DM, 1.0f / (S_HID * S_WDN), (const float*)(ws + T_SA)};
                pg8::gemm_phase<pg8::EpiResidB<true, true>, pg8::StaticOrder, true, true, false, true>(C.lds + RING_OFF, g, S, E, C.wave);
            }
            SEAM(9);
}
__device__ __forceinline__ void ffn_moe(const KArgs ka0, const Ctx& C0, const XcdBarrier& bar, const int lo, const int hi) {
            if (IN(17)) { FRESH(); int par = 0; __syncthreads();
                if (C.G == 256) { for (int x = (int)blockIdx.x; x < 1001 + 496; x += C.G) prep_item(C, ka, ws, x < 1001 ? moe_slab_item(791 + x) : moe_down_item(400 + x - 1001), par); }
                else { for (int it = PI_MOE + (int)blockIdx.x; it < PI_END; it += C.G) prep_item(C, ka, ws, it, par); }
                moe_count(C, ws); } SEAM(17);
            if (IN(18)) { FRESH(); moe_scan(C, ws); if (C.vcu != 0 && C.G == 256) { FRESH(); int par = 0; prep_item(C, ka, ws, moe_slab_item(536 + C.vcu - 1), par); } } SEAM(18);
            if (IN(19)) { FRESH(); moe_assign(C, ws); } SEAM(19);
            if (IN(20)) { FRESH(); const int npall = __builtin_amdgcn_readfirstlane(ldi((const int*)(ws + T_META) + 2)); moe_gather(C, ws, npall); }
            SEAM(20);
            int m0 = 0, m1 = 0, t0 = 0, t1 = 0, mg = 1;
            if (hi > 21 && lo < 26) { FRESH(); const int* meta = (const int*)(ws + T_META);
                const int P0 = __builtin_amdgcn_readfirstlane(ldi(meta + 1)), P = __builtin_amdgcn_readfirstlane(ldi(meta + 2));
                m0 = __builtin_amdgcn_readfirstlane(ldi(meta + 3)); m1 = __builtin_amdgcn_readfirstlane(ldi(meta + 4)); mg = __builtin_amdgcn_readfirstlane(ldi(meta + 5)); t0 = P0 - m0; t1 = (P - P0) - m1; }
            const int tdA = mg ? t0 + t1 : t0, tdB = mg ? 0 : t1;
            const int nlA = (4 * tdA + 7) & ~7, nlB = (4 * tdB + 7) & ~7;
            for (int it = 0; it < 5; ++it) {
                    const int ph = 21 + it;
                    const int dp0 = it == 1 ? m0 + m1 : (it == 2 ? 0 : (it == 3 ? m0 + m1 + t0 : m0)), dnp = it == 0 ? 0 : (it == 1 ? tdA : (it == 2 ? m0 : (it == 3 ? tdB : m1)));
                    const int dlate = it == 1 ? nlA : (it == 3 ? nlB : 0);
                    const size_t dh = (it == 1 || it == 3) ? WS_HT + (it == 3 ? (size_t)t0 * 256 * FF : 0) : WS_HM;
                    const int up0 = it == 0 ? m0 + m1 : (it == 1 ? 0 : m0), unp = it == 0 ? t0 + t1 : (it == 1 ? m0 : (it == 3 ? m1 : 0));
                    const int ulate = it == 1 ? nlA : (it == 3 ? nlB : 0);
                    const size_t uh = it == 0 ? WS_HT : WS_HM;
                    if (IN(ph) && dnp > 0) { FRESH();
                        pg8::Gemm g{(const bf16*)(ws + dh), (const bf16*)(ws + W_MD), dnp * 256, DM, FF / 2};
                        pg8::MoeOrder S; if (dlate) S.base.init(dnp * 256, DM, dlate, (int)blockIdx.x - (C.G - dlate)); else S.base.init(dnp * 256, DM, C.G, (int)blockIdx.x);
                        S.pexp = (const int*)(ws + T_PEXP) + dp0; S.estride = (long)W_MD_STRIDE; S.nlate = 0; S.nA = 0;
                        typedef pg8::EpiMoeDown<(int)offsetof(Args, out), (int)offsetof(Args, ws), WS_XB, T_WGT - T_IDX, T_SAS - T_IDX, DM> EpiMD; EpiMD E{(const int*)(ws + T_IDX) + dp0 * 256, 1.0f / (S_HID * S_WDN)};
                        pg8::gemm_phase<EpiMD, pg8::MoeOrder, true, true, false, true>(C.lds + RING_OFF, g, S, E, C.wave);
                    }
                    if (IN(ph) && unp > 0) { FRESH();
                        pg8::Gemm g{(const bf16*)(ws + WS_XS + (size_t)up0 * 256 * DM), (const bf16*)(ws + W_MGU), unp * 256, 2 * FF, DM / 2};
                        pg8::MoeOrder S; S.base.init(unp * 256, 2 * FF, C.G, (int)blockIdx.x); S.pexp = (const int*)(ws + T_PEXP) + up0; S.estride = (long)W_MGU_STRIDE; S.nlate = ulate; S.nA = 3;
                        pg8::EpiSwiGLUi8 E{ws + uh, FF, (const float*)(ws + T_SAS) + up0 * 256, (const float*)(ws + T_SBM), 7168, S_HID};
                        pg8::gemm_phase<pg8::EpiSwiGLUi8, pg8::MoeOrder, true, true, true>(C.lds + RING_OFF, g, S, E, C.wave);
                    }
                    SEAM(ph);
                }
}
__global__ void __launch_bounds__(NWAVES * 64, 2) fwd(Args args) {
    extern __shared__ __attribute__((aligned(16))) unsigned char lds[];
    Ctx C0;
    C0.lds = (LAS unsigned char*)lds;
    C0.tid = 0; C0.lane = 0; C0.wave = __builtin_amdgcn_readfirstlane((int)threadIdx.x >> 6);
    C0.G = gridDim.x; { const int bx = blockIdx.x; C0.vcu = (C0.G % 8 == 0) ? (bx % 8) * (C0.G / 8) + bx / 8 : bx; }
    C0.gw = C0.vcu * NWAVES + C0.wave; C0.NGW = C0.G * NWAVES;
    const KArgs ka0 = (KArgs)__builtin_amdgcn_kernarg_segment_ptr();
    volatile LAS unsigned* MISC = (volatile LAS unsigned*)(C0.lds + MISC_OFF);
    for (int u = threadIdx.x; u < (LDS_BYTES - LDSCTL_OFF) / 4; u += NWAVES * 64) ((LAS unsigned*)(C0.lds + LDSCTL_OFF))[u] = 0u;
    __syncthreads();
    XcdBarrier bar; bar.bar = (unsigned*)(ka0->ws + WS_CTL) + CW_BAR; bar.x = 0; bar.st = nullptr;
    if (!MK_MULTI) bar = xcd_barrier_post((unsigned*)(ka0->ws + WS_CTL) + CW_BAR, MISC + 8);
    const int lo = ka0->ph_lo, hi = ka0->ph_hi;
    layer_common<0>(ka0, C0, bar, lo, hi);
    ffn_dense(ka0, C0, bar, lo, hi);
    layer_common<1>(ka0, C0, bar, lo, hi);
    ffn_moe(ka0, C0, bar, lo, hi);
}
#undef IN
#undef SEAM

extern "C" void kernel_launch(void* const* d_in, const int* in_sizes, int n_in, void* d_out, int out_size, void* d_ws, size_t ws_size, hipStream_t stream) {
    static int grid = 0;
    if (grid == 0) {
        if (n_in != 19 || in_sizes[0] != M * DM || out_size != M * DM || ws_size < WS_END) { fprintf(stderr, "kernel_launch: unexpected shapes (n_in %d, in0 %d, out %d, ws %zu)\n", n_in, n_in > 0 ? in_sizes[0] : -1, out_size, ws_size); grid = -1; return; }
        int dev = 0, cus = 0, per_cu = 0;
        if (hipGetDevice(&dev) != hipSuccess || hipDeviceGetAttribute(&cus, hipDeviceAttributeMultiprocessorCount, dev) != hipSuccess) { grid = -1; return; }
        if (hipFuncSetAttribute((const void*)fwd, hipFuncAttributeMaxDynamicSharedMemorySize, LDS_BYTES) != hipSuccess) { fprintf(stderr, "kernel_launch: hipFuncSetAttribute failed\n"); grid = -1; return; }
        if (hipOccupancyMaxActiveBlocksPerMultiprocessor(&per_cu, (const void*)fwd, NWAVES * 64, LDS_BYTES) != hipSuccess || per_cu < 1) fprintf(stderr, "kernel_launch: occupancy query reports %d\n", per_cu);
        (void)hipGetLastError();
        grid = cus;
    }
    if (grid < 0) return;
    if (hipMemsetAsync((char*)d_ws + WS_CTL, 0, CTL_ZERO_BYTES, stream) != hipSuccess) return;
    Args a{};
    for (int i = 0; i < 19; ++i) a.in[i] = (const float*)d_in[i];
    a.out = (float*)d_out; a.ws = (unsigned char*)d_ws;
#if MK_MULTI
    for (int p = 0; p < NPH; ++p) { a.ph_lo = p; a.ph_hi = p + 1; hipLaunchKernelGGL(fwd, dim3(grid), dim3(NWAVES * 64), LDS_BYTES, stream, a); }
#else
    a.ph_lo = 0; a.ph_hi = NPH;
    hipLaunchKernelGGL(fwd, dim3(grid), dim3(NWAVES * 64), LDS_BYTES, stream, a);
#endif
}
```

```cpp
#include <hip/hip_runtime.h>
#include <cstdio>
#include <cstdint>
#include <cstddef>
#include <type_traits>
namespace pg8 {
#define PG8_LAS __attribute__((address_space(3)))
typedef unsigned short bf16_t;
typedef short bf16x8 __attribute__((ext_vector_type(8)));
typedef float f32x4 __attribute__((ext_vector_type(4)));
typedef unsigned u32x4 __attribute__((ext_vector_type(4)));
typedef int v4i32 __attribute__((ext_vector_type(4)));
typedef int v8i32 __attribute__((ext_vector_type(8)));

constexpr int BM = 256, BK = 64, HALF = 128, HTB = HALF * BK * 2  , STAGE_BYTES = 8 * HTB, NXCD = 8, WGM = 8;

__host__ __device__ __forceinline__ int lds_byte(int r, int c) { const int st = (r >> 4) * 2 + (c >> 5), rr = r & 15, cc = c & 31, ob = rr * 64 + cc * 2; return st * 1024 + (ob ^ (((ob >> 9) & 1) << 5)); }
__host__ __device__ __forceinline__ void stage_rc(int b, int& R, int& C) { const int st = b / 1024, sb = b % 1024, swz = sb ^ (((sb >> 9) & 1) << 5); R = (st >> 1) * 16 + swz / 64; C = (st & 1) * 32 + (swz % 64) / 2; }
__host__ __device__ __forceinline__ int perm32(int rho) { const int n = rho >> 4, i = rho & 15; return 8 * (i >> 2) + 4 * n + (i & 3); }

__device__ __forceinline__ int pg8_lane_id() { int l; asm volatile("v_mbcnt_lo_u32_b32 %0, -1, 0\n\tv_mbcnt_hi_u32_b32 %0, -1, %0" : "=v"(l)); return l; }
struct Unit { int pm, pn; long boff; int ex; };
struct Gemm { const bf16_t* A; const bf16_t* Bt; int M, N, K; };

struct StaticOrder {
    int nM, nN, nwg, G, c;
    __host__ __device__ void init(int M, int N, int G_, int c_) { nM = M / BM; nN = N / BM; nwg = nM * nN; G = G_; c = c_; }
    __host__ __device__ bool next(int i, Unit& u) const { return at(i * G + c, u); }
    __host__ __device__ bool at(int L, Unit& u) const {
        if (L < 0 || L >= nwg) return false;
        int wgid = L; { const int q = nwg / NXCD, r = nwg % NXCD, xcd = wgid % NXCD, off = wgid / NXCD; wgid = (xcd < r ? xcd * (q + 1) : r * (q + 1) + (xcd - r) * q) + off; }
        const int nig = WGM * nN, gid = wgid / nig, fm = gid * WGM, gsz = (nM - fm) < WGM ? (nM - fm) : WGM;
        u.pm = fm + ((wgid % nig) % gsz); u.pn = (wgid % nig) / gsz; u.boff = 0; u.ex = 0; return true;
    }
    __device__ __forceinline__ void a_ready(const Unit&) const {}
    __device__ __forceinline__ void done(const Unit&) const {}
};

__device__ __forceinline__ unsigned cvt_pk_bf16(float lo, float hi) { unsigned r; asm volatile("v_cvt_pk_bf16_f32 %0, %1, %2" : "=v"(r) : "v"(lo), "v"(hi)); return r; }
__device__ __forceinline__ float silu_f(float v) { return v * __builtin_amdgcn_rcpf(1.0f + __builtin_amdgcn_exp2f(-1.4426950408889634f * v)); }

template <long HGD> struct EpiStoreI8 {
    static constexpr bool PERM = true, AFTER_DRAIN = false;
    bf16_t* O; int ldc; const float* sa; const float* sb; const float* gq; const float* gk;
    struct Pre { f32x4 sbv[2][2]; float sr[2][4]; };
    __device__ __forceinline__ Pre pre(const Unit& u, int wr, int wc, int fr, int fq) const { Pre p;
        const int row0 = u.pm * BM + wr * 64 + fr; const int pcol0 = u.pn * BM + wc * 32 + 8 * fq;
#pragma unroll
        for (int bj = 0; bj < 2; ++bj)
#pragma unroll
            for (int n = 0; n < 2; ++n) p.sbv[bj][n] = *(const f32x4*)(sb + pcol0 + bj * HALF + 4 * n);
#pragma unroll
        for (int ai = 0; ai < 2; ++ai)
#pragma unroll
            for (int m = 0; m < 4; ++m) p.sr[ai][m] = sa[row0 + ai * HALF + m * 16];
        return p; }
    __device__ __forceinline__ void operator()(const f32x4 (&acc)[2][2][4][2], const Unit& u, int wr, int wc, int fr, int fq, const Pre& P) const {
        const int row0 = u.pm * BM + wr * 64 + fr; const int pcol0 = u.pn * BM + wc * 32 + 8 * fq;
        const f32x4 (&sbv)[2][2] = P.sbv; const float (&sr)[2][4] = P.sr;
        if (u.pn < 4) {
            const float* gp = (u.pn < 2 ? gq : gk) + 8 * fq; const float qs = u.pn < 2 ? 0.125f * 1.4426950408889634f : 1.0f;
            f32x4 gv[2][2];
#pragma unroll
            for (int bj = 0; bj < 2; ++bj)
#pragma unroll
                for (int n = 0; n < 2; ++n) gv[bj][n] = *(const f32x4*)(gp + 32 * bj + 4 * n) * qs;
            const int lcol0 = u.pn * BM + wc * 64 + 8 * fq;
#pragma unroll
            for (int ai = 0; ai < 2; ++ai)
#pragma unroll
                for (int m = 0; m < 4; ++m) { const int r = row0 + ai * HALF + m * 16; bf16_t* rowp = O + (size_t)r * ldc + lcol0; const float s = sr[ai][m];
                    f32x4 x[2][2]; float ss = 0.f;
#pragma unroll
                    for (int bj = 0; bj < 2; ++bj)
#pragma unroll
                        for (int n = 0; n < 2; ++n) { const v4i32 iv = __builtin_bit_cast(v4i32, acc[ai][bj][m][n]); const f32x4 sc = sbv[bj][n] * s;
                            x[bj][n] = (f32x4){(float)iv[0] * sc[0], (float)iv[1] * sc[1], (float)iv[2] * sc[2], (float)iv[3] * sc[3]};
                            ss += (x[bj][n][0] * x[bj][n][0] + x[bj][n][1] * x[bj][n][1]) + (x[bj][n][2] * x[bj][n][2] + x[bj][n][3] * x[bj][n][3]); }
                    ss += __shfl_xor(ss, 16); ss += __shfl_xor(ss, 32);
                    const float rn = 1.0f / sqrtf(ss * (1.f / 64.f) + 1e-6f);
#pragma unroll
                    for (int bj = 0; bj < 2; ++bj) { const f32x4 v0 = x[bj][0] * gv[bj][0] * rn, v1 = x[bj][1] * gv[bj][1] * rn;
                        u32x4 w; w.x = cvt_pk_bf16(v0[0], v0[1]); w.y = cvt_pk_bf16(v0[2], v0[3]); w.z = cvt_pk_bf16(v1[0], v1[1]); w.w = cvt_pk_bf16(v1[2], v1[3]);
                        *(u32x4*)(rowp + bj * 32) = w; } }
        } else {
#pragma unroll
            for (int ai = 0; ai < 2; ++ai)
#pragma unroll
                for (int m = 0; m < 4; ++m) { const int r = row0 + ai * HALF + m * 16; const float s = sr[ai][m];
                    bf16_t* rowp; long bjstep;
                    if (u.pn >= 9) { const int cq = pcol0 - 2304; rowp = O + HGD + ((((long)(r >> 6) * 4 + (cq >> 8)) * 4 + ((cq >> 6) & 3)) * 8 + ((cq >> 3) & 7)) * 512 + (r & 63) * 8; bjstep = 2 * 8 * 512; }
                    else { rowp = O + (size_t)r * ldc + pcol0; bjstep = HALF; }
#pragma unroll
                    for (int bj = 0; bj < 2; ++bj) { const v4i32 i0 = __builtin_bit_cast(v4i32, acc[ai][bj][m][0]), i1 = __builtin_bit_cast(v4i32, acc[ai][bj][m][1]);
                        const f32x4 s0 = sbv[bj][0] * s, s1 = sbv[bj][1] * s;
                        u32x4 w; w.x = cvt_pk_bf16((float)i0[0] * s0[0], (float)i0[1] * s0[1]); w.y = cvt_pk_bf16((float)i0[2] * s0[2], (float)i0[3] * s0[3]);
                        w.z = cvt_pk_bf16((float)i1[0] * s1[0], (float)i1[1] * s1[1]); w.w = cvt_pk_bf16((float)i1[2] * s1[2], (float)i1[3] * s1[3]);
                        *(u32x4*)(rowp + bj * bjstep) = w; } }
        }
    }
};
__device__ __forceinline__ unsigned pk4_fp8(float a, float b, float c, float d) {
    a = __builtin_fminf(__builtin_fmaxf(a, -448.f), 448.f); b = __builtin_fminf(__builtin_fmaxf(b, -448.f), 448.f); c = __builtin_fminf(__builtin_fmaxf(c, -448.f), 448.f); d = __builtin_fminf(__builtin_fmaxf(d, -448.f), 448.f);
    unsigned w = 0u; w = __builtin_amdgcn_cvt_pk_fp8_f32(a, b, w, false); w = __builtin_amdgcn_cvt_pk_fp8_f32(c, d, w, true); return w; }
constexpr float S_Y = 16.f;
__device__ __forceinline__ unsigned pk4_i8y(float a, float b, float c, float d) {
    constexpr float MG = 12582912.f, LO = MG - 127.f, HI = MG + 127.f;
    const unsigned t0 = __builtin_bit_cast(unsigned, __builtin_amdgcn_fmed3f(__builtin_fmaf(a, S_Y, MG), LO, HI)), t1 = __builtin_bit_cast(unsigned, __builtin_amdgcn_fmed3f(__builtin_fmaf(b, S_Y, MG), LO, HI));
    const unsigned t2 = __builtin_bit_cast(unsigned, __builtin_amdgcn_fmed3f(__builtin_fmaf(c, S_Y, MG), LO, HI)), t3 = __builtin_bit_cast(unsigned, __builtin_amdgcn_fmed3f(__builtin_fmaf(d, S_Y, MG), LO, HI));
    return __builtin_amdgcn_perm(t1, t0, 0x0c0c0400u) | __builtin_amdgcn_perm(t3, t2, 0x04000c0cu); }
struct EpiSwiGLUi8 {
    static constexpr bool PERM = true, AFTER_DRAIN = false;
    unsigned char* H; int ldc; const float* sa; const float* sb; int sbstride; float hs;
    struct Pre { f32x4 sg0, sg1, su0, su1; float sr[2][4]; };
    __device__ __forceinline__ Pre pre(const Unit& u, int wr, int wc, int fr, int fq) const { Pre p;
        const int row0 = u.pm * BM + wr * 64 + fr; const float* sbp = sb + (size_t)u.ex * sbstride + u.pn * BM + wc * 32 + 8 * fq;
        p.sg0 = *(const f32x4*)(sbp); p.sg1 = *(const f32x4*)(sbp + 4); p.su0 = *(const f32x4*)(sbp + HALF); p.su1 = *(const f32x4*)(sbp + HALF + 4);
#pragma unroll
        for (int ai = 0; ai < 2; ++ai)
#pragma unroll
            for (int m = 0; m < 4; ++m) p.sr[ai][m] = sa[row0 + ai * HALF + m * 16];
        return p; }
    __device__ __forceinline__ void operator()(const f32x4 (&acc)[2][2][4][2], const Unit& u, int wr, int wc, int fr, int fq, const Pre& P) const {
        const int row0 = u.pm * BM + wr * 64 + fr; const int col0 = u.pn * HALF + wc * 32 + 8 * fq;
        const f32x4 sg0 = P.sg0 * 1.4426950408889634f, sg1 = P.sg1 * 1.4426950408889634f, su0 = P.su0 * (hs * 0.6931471805599453f), su1 = P.su1 * (hs * 0.6931471805599453f);
        const float (&sr)[2][4] = P.sr;
#pragma unroll
        for (int ai = 0; ai < 2; ++ai)
#pragma unroll
            for (int m = 0; m < 4; ++m) { const int r = row0 + ai * HALF + m * 16; unsigned char* rowp = H + (size_t)r * ldc + col0;
                const float s = sr[ai][m];
                const v4i32 ig0 = __builtin_bit_cast(v4i32, acc[ai][0][m][0]), ig1 = __builtin_bit_cast(v4i32, acc[ai][0][m][1]), iu0 = __builtin_bit_cast(v4i32, acc[ai][1][m][0]), iu1 = __builtin_bit_cast(v4i32, acc[ai][1][m][1]);
                const f32x4 g0 = __builtin_convertvector(ig0, f32x4) * (sg0 * s), g1 = __builtin_convertvector(ig1, f32x4) * (sg1 * s), u0 = __builtin_convertvector(iu0, f32x4) * su0, u1 = __builtin_convertvector(iu1, f32x4) * su1;
                f32x4 e0, e1;
#pragma unroll
                for (int j = 0; j < 4; ++j) { e0[j] = __builtin_amdgcn_exp2f(-g0[j]); e1[j] = __builtin_amdgcn_exp2f(-g1[j]); }
                e0 = e0 + 1.0f; e1 = e1 + 1.0f;
#pragma unroll
                for (int j = 0; j < 4; ++j) { e0[j] = __builtin_amdgcn_rcpf(e0[j]); e1[j] = __builtin_amdgcn_rcpf(e1[j]); }
                f32x4 h0 = g0 * e0 * u0, h1 = g1 * e1 * u1;
                typedef unsigned u32x2 __attribute__((ext_vector_type(2)));
                u32x2 w; w.x = pk4_fp8(h0[0], h0[1], h0[2], h0[3]); w.y = pk4_fp8(h1[0], h1[1], h1[2], h1[3]);
                *(u32x2*)rowp = w; }
    }
};
template <bool BASE_BF, bool ROWS = false> struct EpiResidB {
    static constexpr bool PERM = true, AFTER_DRAIN = false;
    const void* base; bf16_t* out; int ldc; float scale; const float* rs;
    struct Pre {}; __device__ __forceinline__ Pre pre(const Unit&, int, int, int, int) const { return Pre{}; }
    __device__ __forceinline__ void operator()(const f32x4 (&acc)[2][2][4][2], const Unit& u, int wr, int wc, int fr, int fq, const Pre&) const {
        const int row0 = u.pm * BM + wr * 64 + fr; const int col0 = u.pn * BM + wc * 32 + 8 * fq;
        float rsv[2][4];
#pragma unroll
        for (int ai = 0; ai < 2; ++ai)
#pragma unroll
            for (int m = 0; m < 4; ++m) rsv[ai][m] = ROWS ? this->scale * rs[row0 + ai * HALF + m * 16] : this->scale;
        constexpr int NA = 1;
#pragma unroll
        for (int a0 = 0; a0 < 2; a0 += NA) {
            typedef typename std::conditional<BASE_BF, u32x4, f32x4>::type raw_t;
            raw_t rb[NA][4][2][BASE_BF ? 1 : 2];
#pragma unroll
            for (int ai = a0; ai < a0 + NA; ++ai)
#pragma unroll
            for (int m = 0; m < 4; ++m) { const size_t off = (size_t)(row0 + ai * HALF + m * 16) * ldc + col0;
#pragma unroll
                for (int bj = 0; bj < 2; ++bj) {
                    if constexpr (BASE_BF) rb[ai - a0][m][bj][0] = *(const raw_t*)((const bf16_t*)base + off + bj * HALF);
                    else { rb[ai - a0][m][bj][0] = *(const raw_t*)((const float*)base + off + bj * HALF); rb[ai - a0][m][bj][BASE_BF ? 0 : 1] = *(const raw_t*)((const float*)base + off + bj * HALF + 4); } } }
#pragma unroll
            for (int ai = a0; ai < a0 + NA; ++ai)
#pragma unroll
            for (int m = 0; m < 4; ++m) { const size_t off = (size_t)(row0 + ai * HALF + m * 16) * ldc + col0; const float scale = rsv[ai][m];
#pragma unroll
                for (int bj = 0; bj < 2; ++bj) { f32x4 b0, b1;
                    if constexpr (BASE_BF) { const u32x4 r = __builtin_bit_cast(u32x4, rb[ai - a0][m][bj][0]);
                        b0 = (f32x4){__builtin_bit_cast(float, r.x << 16), __builtin_bit_cast(float, r.x & 0xffff0000u), __builtin_bit_cast(float, r.y << 16), __builtin_bit_cast(float, r.y & 0xffff0000u)};
                        b1 = (f32x4){__builtin_bit_cast(float, r.z << 16), __builtin_bit_cast(float, r.z & 0xffff0000u), __builtin_bit_cast(float, r.w << 16), __builtin_bit_cast(float, r.w & 0xffff0000u)}; }
                    else { b0 = __builtin_bit_cast(f32x4, rb[ai - a0][m][bj][0]); b1 = __builtin_bit_cast(f32x4, rb[ai - a0][m][bj][BASE_BF ? 0 : 1]); }
                    const f32x4 v0 = b0 + scale * acc[ai][bj][m][0], v1 = b1 + scale * acc[ai][bj][m][1];
                    u32x4 w; w.x = cvt_pk_bf16(v0[0], v0[1]); w.y = cvt_pk_bf16(v0[2], v0[3]); w.z = cvt_pk_bf16(v1[0], v1[1]); w.w = cvt_pk_bf16(v1[2], v1[3]);
                    *(u32x4*)(out + off + bj * HALF) = w; } } }
    }
};
template <bool BASE_BF> struct EpiResidI8 {
    static constexpr bool PERM = true, AFTER_DRAIN = false;
    const void* base; bf16_t* out; int ldc; float scale; const float* sb;
    struct Pre { f32x4 sbv[2][2]; };
    __device__ __forceinline__ Pre pre(const Unit& u, int wr, int wc, int fr, int fq) const { Pre p; const float* sbp = sb + u.pn * BM + wc * 32 + 8 * fq;
#pragma unroll
        for (int bj = 0; bj < 2; ++bj)
#pragma unroll
            for (int n = 0; n < 2; ++n) p.sbv[bj][n] = *(const f32x4*)(sbp + bj * HALF + 4 * n);
        return p; }
    __device__ __forceinline__ void operator()(const f32x4 (&acc)[2][2][4][2], const Unit& u, int wr, int wc, int fr, int fq, const Pre& P) const {
        const int row0 = u.pm * BM + wr * 64 + fr; const int col0 = u.pn * BM + wc * 32 + 8 * fq;
        f32x4 sv[2][2];
#pragma unroll
        for (int bj = 0; bj < 2; ++bj)
#pragma unroll
            for (int n = 0; n < 2; ++n) sv[bj][n] = P.sbv[bj][n] * scale;
        constexpr int NA = BASE_BF ? 2 : 1;
#pragma unroll
        for (int a0 = 0; a0 < 2; a0 += NA) {
            typedef typename std::conditional<BASE_BF, u32x4, f32x4>::type raw_t;
            raw_t rb[NA][4][2][BASE_BF ? 1 : 2];
#pragma unroll
            for (int ai = a0; ai < a0 + NA; ++ai)
#pragma unroll
            for (int m = 0; m < 4; ++m) { const size_t off = (size_t)(row0 + ai * HALF + m * 16) * ldc + col0;
#pragma unroll
                for (int bj = 0; bj < 2; ++bj) {
                    if constexpr (BASE_BF) rb[ai - a0][m][bj][0] = *(const raw_t*)((const bf16_t*)base + off + bj * HALF);
                    else { rb[ai - a0][m][bj][0] = *(const raw_t*)((const float*)base + off + bj * HALF); rb[ai - a0][m][bj][BASE_BF ? 0 : 1] = *(const raw_t*)((const float*)base + off + bj * HALF + 4); } } }
#pragma unroll
            for (int ai = a0; ai < a0 + NA; ++ai)
#pragma unroll
            for (int m = 0; m < 4; ++m) { const size_t off = (size_t)(row0 + ai * HALF + m * 16) * ldc + col0;
#pragma unroll
                for (int bj = 0; bj < 2; ++bj) { f32x4 b0, b1;
                    if constexpr (BASE_BF) { const u32x4 r = __builtin_bit_cast(u32x4, rb[ai - a0][m][bj][0]);
                        b0 = (f32x4){__builtin_bit_cast(float, r.x << 16), __builtin_bit_cast(float, r.x & 0xffff0000u), __builtin_bit_cast(float, r.y << 16), __builtin_bit_cast(float, r.y & 0xffff0000u)};
                        b1 = (f32x4){__builtin_bit_cast(float, r.z << 16), __builtin_bit_cast(float, r.z & 0xffff0000u), __builtin_bit_cast(float, r.w << 16), __builtin_bit_cast(float, r.w & 0xffff0000u)}; }
                    else { b0 = __builtin_bit_cast(f32x4, rb[ai - a0][m][bj][0]); b1 = __builtin_bit_cast(f32x4, rb[ai - a0][m][bj][BASE_BF ? 0 : 1]); }
                    const f32x4 v0 = b0 + sv[bj][0] * __builtin_convertvector(__builtin_bit_cast(v4i32, acc[ai][bj][m][0]), f32x4), v1 = b1 + sv[bj][1] * __builtin_convertvector(__builtin_bit_cast(v4i32, acc[ai][bj][m][1]), f32x4);
                    u32x4 w; w.x = cvt_pk_bf16(v0[0], v0[1]); w.y = cvt_pk_bf16(v0[2], v0[3]); w.z = cvt_pk_bf16(v1[0], v1[1]); w.w = cvt_pk_bf16(v1[2], v1[3]);
                    *(u32x4*)(out + off + bj * HALF) = w; } } }
    }
};
template <int KOUT, int KWS, size_t XBOFF, size_t WDELTA, size_t SDELTA, int LDC> struct EpiMoeDown {
    static constexpr bool PERM = true, AFTER_DRAIN = false;
    const int* idx; float scale;
    struct Pre {}; __device__ __forceinline__ Pre pre(const Unit&, int, int, int, int) const { return Pre{}; }
    __device__ __forceinline__ void operator()(const f32x4 (&acc)[2][2][4][2], const Unit& u, int wr, int wc, int fr, int fq, const Pre&) const {
        typedef const __attribute__((address_space(4))) unsigned char* KSeg;
        KSeg ks = (KSeg)__builtin_amdgcn_kernarg_segment_ptr(); asm volatile("" : "+s"(ks));
        float* const out = *(float* const __attribute__((address_space(4)))*)(ks + KOUT); const bf16_t* const xb = (const bf16_t*)(*(unsigned char* const __attribute__((address_space(4)))*)(ks + KWS) + XBOFF);
        const float* const wgt = (const float*)((const unsigned char*)idx + WDELTA); constexpr int ldc = LDC;
        { const int l_ = pg8_lane_id(); fr = l_ & 15; fq = l_ >> 4; }
        const int row0 = u.pm * BM + wr * 64 + fr; const int col0 = u.pn * BM + wc * 32 + 8 * fq;
        int tk[2][4]; float wg[2][4];
#pragma unroll
        for (int ai = 0; ai < 2; ++ai)
#pragma unroll
            for (int m = 0; m < 4; ++m) { tk[ai][m] = idx[row0 + ai * HALF + m * 16]; wg[ai][m] = wgt[row0 + ai * HALF + m * 16] * ((const float*)((const unsigned char*)idx + SDELTA))[row0 + ai * HALF + m * 16]; }
#pragma unroll
        for (int ai = 0; ai < 2; ++ai) {
            u32x4 rb[1][4][2];
#pragma unroll
            for (int m = 0; m < 4; ++m) { const int tv = tk[ai][m]; const size_t off = (size_t)(tv >= 0 ? (tv & 0x3fffffff) : 0) * ldc + col0;
#pragma unroll
                for (int bj = 0; bj < 2; ++bj) rb[0][m][bj] = *(const u32x4*)(xb + off + bj * HALF); }
#pragma unroll
            for (int m = 0; m < 4; ++m) {
                const int tv = tk[ai][m]; const float w = scale * wg[ai][m];
                if (tv >= 0) { const size_t off = (size_t)(tv & 0x3fffffff) * ldc + col0;
                    if (tv >> 30) {
#pragma unroll
                        for (int bj = 0; bj < 2; ++bj) { const u32x4 r = rb[0][m][bj];
                            const f32x4 b0 = (f32x4){__builtin_bit_cast(float, r.x << 16), __builtin_bit_cast(float, r.x & 0xffff0000u), __builtin_bit_cast(float, r.y << 16), __builtin_bit_cast(float, r.y & 0xffff0000u)};
                            const f32x4 b1 = (f32x4){__builtin_bit_cast(float, r.z << 16), __builtin_bit_cast(float, r.z & 0xffff0000u), __builtin_bit_cast(float, r.w << 16), __builtin_bit_cast(float, r.w & 0xffff0000u)};
                            const f32x4 v0 = b0 + w * acc[ai][bj][m][0], v1 = b1 + w * acc[ai][bj][m][1];
                            u32x4 o; o.x = cvt_pk_bf16(v0[0], v0[1]); o.y = cvt_pk_bf16(v0[2], v0[3]); o.z = cvt_pk_bf16(v1[0], v1[1]); o.w = cvt_pk_bf16(v1[2], v1[3]);
                            *(u32x4*)(const_cast<bf16_t*>(xb) + off + bj * HALF) = o; }
                    } else {
#pragma unroll
                        for (int bj = 0; bj < 2; ++bj) { const u32x4 r = rb[0][m][bj];
                            const f32x4 b0 = (f32x4){__builtin_bit_cast(float, r.x << 16), __builtin_bit_cast(float, r.x & 0xffff0000u), __builtin_bit_cast(float, r.y << 16), __builtin_bit_cast(float, r.y & 0xffff0000u)};
                            const f32x4 b1 = (f32x4){__builtin_bit_cast(float, r.z << 16), __builtin_bit_cast(float, r.z & 0xffff0000u), __builtin_bit_cast(float, r.w << 16), __builtin_bit_cast(float, r.w & 0xffff0000u)};
                            *(f32x4*)(out + off + bj * HALF) = b0 + w * acc[ai][bj][m][0]; *(f32x4*)(out + off + bj * HALF + 4) = b1 + w * acc[ai][bj][m][1]; }
                    } } } }
    }
};
struct MoeOrder {
    StaticOrder base; const int* pexp; long estride; int nlate, nA;
    __device__ __forceinline__ bool next(int i, Unit& u) const {
        int L;
        if (nlate == 0) L = i * base.G + base.c;
        else { const int ne = base.G - nlate; if (base.c < ne) L = i < nA ? i * ne + base.c : nA * ne + (i - nA) * base.G + base.c; else L = nA * ne + i * base.G + base.c; }
        if (!base.at(L, u)) return false;
        u.ex = __builtin_amdgcn_readfirstlane(__hip_atomic_load(pexp + u.pm, __ATOMIC_RELAXED, __HIP_MEMORY_SCOPE_AGENT)); u.boff = (long)u.ex * estride; return true; }
    __device__ __forceinline__ void a_ready(const Unit&) const {}
    __device__ __forceinline__ void done(const Unit&) const {}
};

template <class Epi, class Sched, bool ALIGN_EPI = false, bool SP2 = false, bool I8 = false, bool F8 = false>
__device__ __forceinline__ void gemm_phase(PG8_LAS unsigned char* lds, const Gemm g, const Sched& S, const Epi& E, const int wid_in  ) {
    const int lane = pg8_lane_id(), wid = wid_in, tid = wid * 64 + lane, wr = wid >> 2, wc = wid & 3, fr = lane & 15, fq = lane >> 4;
    const int K = g.K, nt = K / BK;
    unsigned voffA[2], voffB[2];
#pragma unroll
    for (int i = 0; i < 2; ++i) { int R, C; stage_rc(tid * 16 + i * 8192, R, C); const int Rb = Epi::PERM ? ((R & ~31) + perm32(R & 31)) : R;
        voffA[i] = (unsigned)(R * K + C) * 2u; voffB[i] = (unsigned)(Rb * K + C) * 2u; }
    const size_t kstep = (size_t)(BK * 2);
    const size_t hstep = (size_t)HALF * K * 2;
    const size_t tstep = 2 * hstep;
    const unsigned ldsw = (unsigned)wid * 1024u;
    const unsigned ldsu = (unsigned)__builtin_amdgcn_readfirstlane((int)((unsigned)(size_t)lds + ldsw));
    const int aoff = lds_byte(wr * 64 + fr, fq * 8), boff = lds_byte(wc * 32 + fr, fq * 8);
#define PG8_SA(b, h) (((b) * 2 + (h)) * HTB)
#define PG8_SB(b, h) ((4 + (b) * 2 + (h)) * HTB)
#define PG8_STAGE(bufoff, gbase, voff) do { _Pragma("unroll") for (int _i = 0; _i < 2; ++_i) { unsigned keep_; \
        asm volatile("s_mov_b32 %0, m0\n\ts_mov_b32 m0, %3\n\ts_nop 4\n\tglobal_load_lds_dwordx4 %1, %2\n\ts_mov_b32 m0, %0" : "=&s"(keep_) : "v"((voff)[_i]), "s"((const void*)(gbase)), "s"(ldsu + (unsigned)((bufoff) + _i * 8192)) : "memory"); } } while (0)
#define PG8_LDA(dst, b, h) do { _Pragma("unroll") for (int m = 0; m < 4; ++m) _Pragma("unroll") for (int k = 0; k < 2; ++k) dst[m][k] = *(const PG8_LAS bf16x8*)(lds + PG8_SA(b, h) + aoff + m * 2048 + k * 1024); } while (0)
#define PG8_LDB(dst, b, h) do { _Pragma("unroll") for (int n = 0; n < 2; ++n) _Pragma("unroll") for (int k = 0; k < 2; ++k) dst[n][k] = *(const PG8_LAS bf16x8*)(lds + PG8_SB(b, h) + boff + n * 2048 + k * 1024); } while (0)
#define PG8_CAT8(x) __builtin_shufflevector(__builtin_bit_cast(v4i32, x[0]), __builtin_bit_cast(v4i32, x[1]), 0, 1, 2, 3, 4, 5, 6, 7)
#define PG8_MMA(ai, bj, At, Bt) do { if constexpr (F8) { __builtin_amdgcn_sched_barrier(0); __builtin_amdgcn_s_setprio(1); _Pragma("unroll") for (int m = 0; m < 4; ++m) _Pragma("unroll") for (int n = 0; n < 2; ++n) \
        acc[ai][bj][m][n] = __builtin_amdgcn_mfma_scale_f32_16x16x128_f8f6f4(PG8_CAT8(Bt[n]), PG8_CAT8(At[m]), acc[ai][bj][m][n], 0, 0, 0, 0, 0, 0); __builtin_amdgcn_s_setprio(0); __builtin_amdgcn_sched_barrier(0); } else { \
        __builtin_amdgcn_s_setprio(1); _Pragma("unroll") for (int m = 0; m < 4; ++m) _Pragma("unroll") for (int n = 0; n < 2; ++n) _Pragma("unroll") for (int k = 0; k < 2; ++k) \
        { if constexpr (I8) acc[ai][bj][m][n] = __builtin_bit_cast(f32x4, __builtin_amdgcn_mfma_i32_16x16x64_i8(__builtin_bit_cast(v4i32, Bt[n][k]), __builtin_bit_cast(v4i32, At[m][k]), __builtin_bit_cast(v4i32, acc[ai][bj][m][n]), 0, 0, 0)); \
        else acc[ai][bj][m][n] = __builtin_amdgcn_mfma_f32_16x16x32_bf16(Bt[n][k], At[m][k], acc[ai][bj][m][n], 0, 0, 0); } __builtin_amdgcn_s_setprio(0); } } while (0)
#define PG8_WAIT_V(n) asm volatile("s_waitcnt vmcnt(" #n ")" ::: "memory")
#define PG8_WAIT_L(n) asm volatile("s_waitcnt lgkmcnt(" #n ")" ::: "memory")
#define PG8_BAR __builtin_amdgcn_s_barrier()
#define PG8_SCHED __builtin_amdgcn_sched_barrier(0)
    Unit cur, nxt; int ui = 0;
    if (!S.next(0, cur)) return;
    f32x4 acc[2][2][4][2];
#pragma unroll
    for (int a = 0; a < 2; ++a)
#pragma unroll
        for (int b = 0; b < 2; ++b)
#pragma unroll
            for (int m = 0; m < 4; ++m)
#pragma unroll
                for (int n = 0; n < 2; ++n) acc[a][b][m][n] = (f32x4){0.f, 0.f, 0.f, 0.f};
    bf16x8 At[4][2], B0[2][2], B1[2][2];
    const char* cA = (const char*)g.A + (size_t)cur.pm * tstep; const char* cB = (const char*)g.Bt + (size_t)cur.pn * tstep + cur.boff;
    S.a_ready(cur);
    typename Epi::Pre pre = E.pre(cur, wr, wc, fr, fq);
    if constexpr (SP2) {
        PG8_STAGE(PG8_SB(0, 0), cB, voffB); PG8_STAGE(PG8_SB(0, 1), cB + hstep, voffB); PG8_STAGE(PG8_SA(0, 0), cA, voffA); PG8_STAGE(PG8_SA(0, 1), cA + hstep, voffA);
        if (wr == 1) PG8_BAR;
        PG8_WAIT_V(2); PG8_BAR;
        PG8_STAGE(PG8_SB(1, 0), cB + kstep, voffB); PG8_STAGE(PG8_SA(1, 0), cA + kstep, voffA); PG8_STAGE(PG8_SB(1, 1), cB + hstep + kstep, voffB);
        PG8_WAIT_V(6); PG8_BAR;
    } else {
        PG8_STAGE(PG8_SB(0, 0), cB, voffB); PG8_STAGE(PG8_SA(0, 0), cA, voffA); PG8_STAGE(PG8_SB(0, 1), cB + hstep, voffB); PG8_STAGE(PG8_SA(0, 1), cA + hstep, voffA);
        if (wr == 1) PG8_BAR;
        PG8_WAIT_V(4); PG8_BAR;
        PG8_STAGE(PG8_SB(1, 0), cB + kstep, voffB); PG8_STAGE(PG8_SA(1, 0), cA + kstep, voffA); PG8_STAGE(PG8_SB(1, 1), cB + hstep + kstep, voffB);
        PG8_WAIT_V(6); PG8_BAR;
    }
    for (;;) {
        const bool has_next = S.next(ui + 1, nxt);
        const char* nA = has_next ? (const char*)g.A + (size_t)nxt.pm * tstep : cA; const char* nB = has_next ? (const char*)g.Bt + (size_t)nxt.pn * tstep + nxt.boff : cB;
        for (int t = 0; t < nt; t += 2) {
            const bool last = (t == nt - 2);
            const char* a1 = cA + (size_t)(t + 1) * kstep;
            const char* a2 = last ? nA : cA + (size_t)(t + 2) * kstep; const char* b2 = last ? nB : cB + (size_t)(t + 2) * kstep;
            const char* a3 = a2 + kstep; const char* b3 = b2 + kstep;
            if (last && has_next) S.a_ready(nxt);
            if constexpr (SP2) {
            PG8_LDB(B0, 0, 0); PG8_LDB(B1, 0, 1); PG8_SCHED; PG8_LDA(At, 0, 0); PG8_STAGE(PG8_SA(1, 1), a1 + hstep, voffA);
            PG8_WAIT_V(8); PG8_WAIT_L(0); PG8_BAR; PG8_MMA(0, 0, At, B0); PG8_MMA(0, 1, At, B1); PG8_BAR; PG8_SCHED;
            PG8_LDA(At, 0, 1); PG8_STAGE(PG8_SB(0, 0), b2, voffB); PG8_STAGE(PG8_SB(0, 1), b2 + hstep, voffB); PG8_STAGE(PG8_SA(0, 0), a2, voffA);
            PG8_WAIT_V(8); PG8_WAIT_L(0); PG8_BAR; PG8_MMA(1, 0, At, B0); PG8_MMA(1, 1, At, B1); PG8_BAR; PG8_SCHED;
            PG8_LDB(B0, 1, 0); PG8_LDB(B1, 1, 1); PG8_SCHED; PG8_LDA(At, 1, 0); PG8_STAGE(PG8_SA(0, 1), a2 + hstep, voffA);
            PG8_WAIT_V(8); PG8_WAIT_L(0); PG8_BAR; PG8_MMA(0, 0, At, B0); PG8_MMA(0, 1, At, B1); PG8_BAR; PG8_SCHED;
            PG8_LDA(At, 1, 1); PG8_STAGE(PG8_SB(1, 0), b3, voffB); PG8_STAGE(PG8_SB(1, 1), b3 + hstep, voffB); PG8_STAGE(PG8_SA(1, 0), a3, voffA);
            PG8_WAIT_V(8); PG8_WAIT_L(0); PG8_BAR; PG8_MMA(1, 0, At, B0); PG8_MMA(1, 1, At, B1); PG8_BAR; PG8_SCHED;
            } else {
            PG8_LDB(B0, 0, 0); PG8_SCHED; PG8_LDA(At, 0, 0); PG8_STAGE(PG8_SA(1, 1), a1 + hstep, voffA);
            PG8_WAIT_L(8); PG8_BAR; PG8_WAIT_L(0); PG8_MMA(0, 0, At, B0); PG8_BAR; PG8_SCHED;
            PG8_LDB(B1, 0, 1); PG8_STAGE(PG8_SB(0, 0), b2, voffB);
            PG8_BAR; PG8_WAIT_L(0); PG8_MMA(0, 1, At, B1); PG8_BAR;
            PG8_LDA(At, 0, 1); PG8_STAGE(PG8_SA(0, 0), a2, voffA);
            PG8_BAR; PG8_WAIT_L(0); PG8_MMA(1, 0, At, B0); PG8_BAR; PG8_SCHED;
            PG8_STAGE(PG8_SB(0, 1), b2 + hstep, voffB);
            PG8_WAIT_V(6); PG8_BAR; PG8_MMA(1, 1, At, B1); PG8_BAR;
            PG8_LDB(B0, 1, 0); PG8_SCHED; PG8_LDA(At, 1, 0); PG8_STAGE(PG8_SA(0, 1), a2 + hstep, voffA);
            PG8_WAIT_L(8); PG8_BAR; PG8_WAIT_L(0); PG8_MMA(0, 0, At, B0); PG8_BAR; PG8_SCHED;
            PG8_LDB(B1, 1, 1); PG8_STAGE(PG8_SB(1, 0), b3, voffB);
            PG8_BAR; PG8_WAIT_L(0); PG8_MMA(0, 1, At, B1); PG8_BAR;
            PG8_LDA(At, 1, 1); PG8_STAGE(PG8_SA(1, 0), a3, voffA);
            PG8_BAR; PG8_WAIT_L(0); PG8_MMA(1, 0, At, B0); PG8_BAR; PG8_SCHED;
            PG8_STAGE(PG8_SB(1, 1), b3 + hstep, voffB);
            PG8_WAIT_V(6); PG8_BAR; PG8_MMA(1, 1, At, B1); PG8_BAR;
            }
        }
        if constexpr (ALIGN_EPI) { if (wr == 0) PG8_BAR; }
        if constexpr (!Epi::AFTER_DRAIN) { E(acc, cur, wr, wc, fr, fq, pre); S.done(cur); }
        if (!has_next) break;
#pragma unroll
        for (int a = 0; a < 2; ++a)
#pragma unroll
            for (int b = 0; b < 2; ++b)
#pragma unroll
                for (int m = 0; m < 4; ++m)
#pragma unroll
                    for (int n = 0; n < 2; ++n) acc[a][b][m][n] = (f32x4){0.f, 0.f, 0.f, 0.f};
        cur = nxt; cA = nA; cB = nB; ++ui; pre = E.pre(cur, wr, wc, fr, fq);
        if constexpr (ALIGN_EPI) { if (wr == 1) PG8_BAR; }
    }
    PG8_WAIT_V(0);
    if constexpr (!ALIGN_EPI) { if (wr == 0) PG8_BAR; }
    PG8_BAR;
    if constexpr (Epi::AFTER_DRAIN) { E.fused(acc, cur, wr, wc, fr, fq, lds, wid, lane); S.done(cur); }
#undef PG8_SA
#undef PG8_SB
#undef PG8_STAGE
#undef PG8_LDA
#undef PG8_LDB
#undef PG8_MMA
#undef PG8_CAT8
#undef PG8_WAIT_V
#undef PG8_WAIT_L
#undef PG8_BAR
#undef PG8_SCHED
}
}
constexpr int NWAVES = 8;
constexpr int BATCH = 4, SEQ = 8192, DM = 1024, M = BATCH * SEQ;
constexpr int DIN = 3336;
constexpr int ZP = 2304;
constexpr int NZ = 3328;
constexpr int FF = 3584, NE = 8;
constexpr int CH_PANELS = 160, CH_ROWS = CH_PANELS * 256;
constexpr float EPS = 1e-6f;
constexpr float S_HID = 0.125f, S_WDN = 512.f;
constexpr int ZQ = 0, ZK = 512, ZV = 1024, ZCX = 1536, ZCB = 1792, ZCC = 2048, ZRQ = 2304, ZRF = 2560, ZRI = 2816, ZRG = 3072;
constexpr int MAXROWS = 2 * (M + NE * 256);
constexpr int MAXPANELS = MAXROWS / 256;

constexpr size_t MiB = 1u << 20;
constexpr size_t WS_CTL = 0, CTL_ZERO_BYTES = 160 * 1024;
constexpr size_t WS_TAB = 1 * MiB;
constexpr size_t T_LSIG = WS_TAB, T_DCUM = WS_TAB + 1 * MiB;
constexpr size_t T_TOPE = WS_TAB + 2 * MiB, T_TOPW = T_TOPE + 256 * 1024;
constexpr size_t T_CNT = T_TOPW + 256 * 1024, T_CBASE = T_CNT + 32 * 1024;
constexpr size_t T_IDX = WS_TAB + 3 * MiB, T_WGT = T_IDX + 512 * 1024;
constexpr size_t T_PEXP = WS_TAB + 4 * MiB, T_META = T_PEXP + 4096, T_LB = T_META + 4096, T_JT0 = T_LB + 4096;
constexpr size_t T_DK2 = WS_TAB + 5 * MiB;
constexpr size_t T_SA = WS_TAB + 6 * MiB, T_SAS = T_SA + 128 * 1024, T_SBF = T_SAS + 384 * 1024, T_SBM = T_SBF + 32 * 1024, T_SBIN = T_SBM + 256 * 1024, T_SBO = T_SBIN + 32 * 1024;
constexpr size_t WS_W0 = 9 * MiB;
constexpr size_t W_IN = WS_W0, W_IN_STRIDE = (size_t)NZ * DM * 2;
constexpr size_t W_OUT = WS_W0 + 13 * MiB, W_OUT_STRIDE = 2 * MiB;
constexpr size_t W_FGU = WS_W0 + 17 * MiB, W_FD = WS_W0 + 31 * MiB;
constexpr size_t WS_S = 49 * MiB;
constexpr size_t WS_HG = WS_S + (size_t)32768 * ZP * 2;
constexpr size_t W_MGU = 449 * MiB, W_MGU_STRIDE = (size_t)2 * FF * DM, W_MD = W_MGU + 56 * MiB, W_MD_STRIDE = (size_t)DM * FF;
constexpr size_t WS_XS = WS_S + 112 * MiB;
constexpr size_t WS_A = 257 * MiB;
constexpr size_t WS_B = 321 * MiB;
constexpr size_t WS_XB = 385 * MiB;
constexpr size_t WS_HD = WS_S;
constexpr size_t WS_HT = WS_A, WS_HM = WS_A + 14 * MiB;
constexpr size_t WS_END = 533 * MiB;
static_assert(WS_HM + (size_t)128 * 256 * FF <= WS_XB && WS_HD + (size_t)M * FF <= WS_A && (size_t)16 * 256 * FF <= WS_HM - WS_HT && WS_HG + (size_t)M * 1024 * 2 <= WS_A && W_MGU >= WS_XB + (size_t)M * DM * 2 && W_MD + 8 * W_MD_STRIDE <= WS_END && WS_XS + (size_t)MAXROWS * DM <= WS_A && W_FD + (size_t)DM * FF * 2 <= WS_S && T_SBIN + 2 * NZ * 4 <= T_SBO && T_SBO + 2 * DM * 4 <= WS_W0, "d_ws map");
constexpr size_t CMAX_OFF = 256 * 1024, CMAXIN_OFF = 768 * 1024;
constexpr size_t CNT_CTL_OFF = 128 * 1024;
constexpr int CW_BAR = 4096;

constexpr int RING_OFF = 0, RING_BYTES = 131072;
constexpr int LDSCTL_OFF = RING_BYTES, MISC_OFF = LDSCTL_OFF + 320;
constexpr int LDS_BYTES = 147456;

#define GAS __attribute__((address_space(1)))
#define LAS __attribute__((address_space(3)))
typedef unsigned short bf16;
typedef unsigned v4u __attribute__((ext_vector_type(4)));
typedef unsigned v2u __attribute__((ext_vector_type(2)));
typedef float f32x4 __attribute__((ext_vector_type(4)));
typedef GAS unsigned gu32;
#define RLX_AGENT __ATOMIC_RELAXED, __HIP_MEMORY_SCOPE_AGENT
#define LDS_WAIT() asm volatile("s_waitcnt lgkmcnt(0)" ::: "memory")
#define VM_WAIT() asm volatile("s_waitcnt vmcnt(0)" ::: "memory")
__device__ __forceinline__ unsigned pk2(float lo, float hi) { unsigned r; asm("v_cvt_pk_bf16_f32 %0, %1, %2" : "=v"(r) : "v"(lo), "v"(hi)); return r; }
__device__ __forceinline__ unsigned f2bf(float f) { return pk2(f, f) & 0xffffu; }
__device__ __forceinline__ float bf2f(unsigned short b) { return __builtin_bit_cast(float, (unsigned)b << 16); }
__device__ __forceinline__ float bflo(unsigned w) { return __builtin_bit_cast(float, w << 16); }
__device__ __forceinline__ float bfhi(unsigned w) { return __builtin_bit_cast(float, w & 0xffff0000u); }
__device__ __forceinline__ int ldi(const int* p) { return __hip_atomic_load(p, RLX_AGENT); }
#define DPPF(x, ctrl, rmask) __builtin_bit_cast(float, __builtin_amdgcn_update_dpp(0, __builtin_bit_cast(int, x), ctrl, rmask, 0xF, false))
__device__ __forceinline__ float wave_sum(float v) {
    v += DPPF(v, 0xB1, 0xF); v += DPPF(v, 0x4E, 0xF); v += DPPF(v, 0x141, 0xF); v += DPPF(v, 0x140, 0xF);
    v += DPPF(v, 0x142, 0xA); v += DPPF(v, 0x143, 0xC);
    return __builtin_bit_cast(float, __builtin_amdgcn_readlane(__builtin_bit_cast(int, v), 63));
}
__device__ __forceinline__ float wave_max_nonneg(float v) {
    v = fmaxf(v, DPPF(v, 0xB1, 0xF)); v = fmaxf(v, DPPF(v, 0x4E, 0xF)); v = fmaxf(v, DPPF(v, 0x141, 0xF)); v = fmaxf(v, DPPF(v, 0x140, 0xF));
    v = fmaxf(v, DPPF(v, 0x142, 0xA)); v = fmaxf(v, DPPF(v, 0x143, 0xC));
    return __builtin_bit_cast(float, __builtin_amdgcn_readlane(__builtin_bit_cast(int, v), 63));
}

#define XB_TMO      128
#define XB_XCNT(j)  (256  + 64 * (j))
#define XB_XSUB(j)  (1280 + 64 * (j))
#define XB_XGEN(j)  (2304 + 64 * (j))
#define XB_TOP      3328
#define XB_TOPGEN   3392
#define XCD_BAR_WORDS 3456
#define XB_SPIN_CAP (1u << 18)

__device__ __forceinline__ unsigned xb_ld(unsigned* p)              { return __hip_atomic_load(p, __ATOMIC_RELAXED, __HIP_MEMORY_SCOPE_AGENT); }
__device__ __forceinline__ unsigned xb_add(unsigned* p, unsigned v) { return __hip_atomic_fetch_add(p, v, __ATOMIC_RELAXED, __HIP_MEMORY_SCOPE_AGENT); }
__device__ __forceinline__ unsigned xb_xcc_id() { return (unsigned)__builtin_amdgcn_s_getreg((3 << 11) | 20) & 0xFu; }
#define XB_SPIN(cond, bar) do { unsigned _sp = 0; while (cond) { __builtin_amdgcn_s_sleep(1); \
    if ((++_sp & 255u) == 0u) { if (xb_ld(&(bar)[XB_TMO])) break; if (_sp > XB_SPIN_CAP) { atomicAdd(&(bar)[XB_TMO], 1u); break; } } } } while (0)

struct XcdBarrier {
    unsigned* bar; unsigned x;
    volatile LAS unsigned* st;
};

__device__ __forceinline__ XcdBarrier xcd_barrier_post(unsigned* bar, volatile LAS unsigned* st) {
    XcdBarrier b; b.bar = bar; b.x = xb_xcc_id(); b.st = st;
    if (threadIdx.x == 0) (void)xb_add(&bar[XB_XCNT(b.x)], 1u);
    return b;
}
__device__ __forceinline__ void xcd_barrier_complete(unsigned* bar, unsigned x, unsigned& nloc, unsigned& nx) {
    const unsigned G = gridDim.x * gridDim.y * gridDim.z;
    unsigned sum, cnt, mine, sp = 0u;
    for (;;) {
        sum = 0u; cnt = 0u; mine = 0u;
#pragma unroll
        for (unsigned j = 0; j < 16; ++j) { const unsigned c = xb_ld(&bar[XB_XCNT(j)]); sum += c; cnt += (c > 0u) ? 1u : 0u; mine = (j == x) ? c : mine; }
        if (sum == G) break;
        __builtin_amdgcn_s_sleep(1);
        if ((++sp & 255u) == 0u) { if (xb_ld(&bar[XB_TMO])) break; if (sp > XB_SPIN_CAP) { atomicAdd(&bar[XB_TMO], 1u); break; } }
    }
    nloc = mine > 0u ? mine : 1u; nx = cnt > 0u ? cnt : 1u;
}

__device__ __forceinline__ void xcd_barrier(const XcdBarrier& b) {
    asm volatile("s_waitcnt vmcnt(0)" ::: "memory");
    __syncthreads();
    if (threadIdx.x == 0) {
        unsigned* bar = b.bar;
        __builtin_amdgcn_s_waitcnt(0);
        unsigned nloc = b.st[0], nx = b.st[1];
        if (nloc == 0u) { xcd_barrier_complete(bar, b.x, nloc, nx); b.st[0] = nloc; b.st[1] = nx; }
        const unsigned old = xb_add(&bar[XB_XSUB(b.x)], 1u);
        const unsigned gen = old / nloc;
        if (old + 1u == (gen + 1u) * nloc) {
            __builtin_amdgcn_fence(__ATOMIC_RELEASE, "agent");
            asm volatile("s_waitcnt vmcnt(0)" ::: "memory");
            const unsigned og = xb_add(&bar[XB_TOP], 1u);
            const unsigned tg = og / nx;
            if (og + 1u == (tg + 1u) * nx) xb_add(&bar[XB_TOPGEN], 1u);
            else XB_SPIN(xb_ld(&bar[XB_TOPGEN]) == tg, bar);
            __builtin_amdgcn_fence(__ATOMIC_ACQUIRE, "agent");
            asm volatile("s_waitcnt vmcnt(0)" ::: "memory");
        } else {
            XB_SPIN(xb_ld(&bar[XB_TOPGEN]) == gen, bar);
            __builtin_amdgcn_fence(__ATOMIC_ACQUIRE, "agent");
            asm volatile("s_waitcnt vmcnt(0)" ::: "memory");
        }
    }
    __syncthreads();
}
#include <hip/hip_bf16.h>
#include <cmath>
namespace attn_body {
using bf16=__hip_bfloat16;
using bf16x8=__attribute__((ext_vector_type(8)))short;
using s16x4=__attribute__((ext_vector_type(4)))short;
using f32x16=__attribute__((ext_vector_type(16)))float;
using u32x4=__attribute__((ext_vector_type(4)))unsigned;
constexpr int BATCH=4,NHEAD=8,SEQ=8192,D=64,PQ=2304,PO=1024;
constexpr int NW=8,QBLK=32,QB=QBLK*NW,KVBLK=64,NQB=SEQ/QB;
constexpr int ATTN_UNIT_ROWS=QB;
__device__ __forceinline__ int crow(int r,int hi){return (r&3)+8*(r>>2)+4*hi;}
#define SBAR() __builtin_amdgcn_sched_barrier(0)
__device__ __forceinline__ void cmask(f32x16&p0,f32x16&p1,int jb,int qrel,int hi){
  const float NEG=-INFINITY; int kb=64*jb+4*hi;
  #pragma unroll
  for(int r=0;r<16;++r){int kv=kb+(r&3)+8*(r>>2); if(kv>qrel)p0[r]=NEG; if(kv+32>qrel)p1[r]=NEG;}
}

constexpr int NSLOT=3, SLOTB=8192;
constexpr int LDS_QPF=98304;
constexpr int LDS_K=0, LDS_V=NSLOT*SLOTB, LDS_WS=2*NSLOT*SLOTB, LDS_OST=LDS_WS+NW*64*4, LDS_DK=LDS_OST+NW*4096, LDS_BYTES=LDS_DK+NW*NSLOT*256;
constexpr float C2=0.125f*1.4426950408889634f;
__device__ __forceinline__ void glds16(const void*gsrc,unsigned lds_dst){unsigned keep;
  asm volatile("s_mov_b32 %0, m0\n\ts_mov_b32 m0, %2\n\ts_nop 0\n\tglobal_load_lds_dwordx4 %1, off\n\ts_mov_b32 m0, %0":"=&s"(keep):"v"(gsrc),"s"(lds_dst):"memory");}
__device__ __forceinline__ void glds4(const void*gsrc,unsigned lds_dst){unsigned keep;
  asm volatile("s_mov_b32 %0, m0\n\ts_mov_b32 m0, %2\n\ts_nop 0\n\tglobal_load_lds_dword %1, off\n\ts_mov_b32 m0, %0":"=&s"(keep):"v"(gsrc),"s"(lds_dst):"memory");}
__device__ __forceinline__ void glds16s(const void*sbase,unsigned voff,unsigned lds_dst){unsigned keep;
  asm volatile("s_mov_b32 %0, m0\n\ts_mov_b32 m0, %3\n\ts_nop 4\n\tglobal_load_lds_dwordx4 %1, %2\n\ts_mov_b32 m0, %0":"=&s"(keep):"v"(voff),"s"(sbase),"s"(lds_dst):"memory");}
__device__ __forceinline__ void glds4s(const void*sbase,unsigned voff,unsigned lds_dst){unsigned keep;
  asm volatile("s_mov_b32 %0, m0\n\ts_mov_b32 m0, %3\n\ts_nop 4\n\tglobal_load_lds_dword %1, %2\n\ts_mov_b32 m0, %0":"=&s"(keep):"v"(voff),"s"(sbase),"s"(lds_dst):"memory");}
__device__ __forceinline__ float max3f(float a,float b,float c){float r;asm("v_max3_f32 %0, %1, %2, %3":"=v"(r):"v"(a),"v"(b),"v"(c));return r;}
__device__ __forceinline__ float max2f(float a,float b){float r;asm("v_max_f32_e32 %0, %1, %2":"=v"(r):"v"(a),"v"(b));return r;}
__device__ __forceinline__ float fadd_s(float a,float b){float r;asm("v_add_f32_e32 %0, %1, %2":"=v"(r):"v"(a),"v"(b));return r;}
__device__ __forceinline__ float fsub_s(float a,float b){float r;asm("v_sub_f32_e32 %0, %1, %2":"=v"(r):"v"(a),"v"(b));return r;}
typedef float f32x2_t __attribute__((ext_vector_type(2))); typedef __bf16 bf16x2_t __attribute__((ext_vector_type(2)));
__device__ __forceinline__ unsigned cvtpk_s(float lo,float hi){f32x2_t v={lo,hi};bf16x2_t b=__builtin_convertvector(v,bf16x2_t);return __builtin_bit_cast(unsigned,b);}
#define WAIT_BAR(N) asm volatile("s_waitcnt vmcnt(" #N ") lgkmcnt(0)\n\ts_barrier":::"memory")

__device__ __forceinline__ void qkt(f32x16&p0,f32x16&p1,const char*Kslot,const bf16x8*qr,int r32,int hi){ const f32x16 zz=f32x16{};
  const char*kb=Kslot+hi*1024+r32*16;
  #pragma unroll
  for(int d0=0;d0<4;++d0){
    const bf16x8 b0=*reinterpret_cast<const bf16x8*>(kb+d0*2048);
    const bf16x8 b1=*reinterpret_cast<const bf16x8*>(kb+d0*2048+512);
    if(d0==0){p0=__builtin_amdgcn_mfma_f32_32x32x16_bf16(b0,qr[0],zz,0,0,0);p1=__builtin_amdgcn_mfma_f32_32x32x16_bf16(b1,qr[0],zz,0,0,0);}
    else{p0=__builtin_amdgcn_mfma_f32_32x32x16_bf16(b0,qr[d0],p0,0,0,0);p1=__builtin_amdgcn_mfma_f32_32x32x16_bf16(b1,qr[d0],p1,0,0,0);}}
}
typedef __attribute__((address_space(3))) const char* lds_cptr;
typedef short v4i16_t __attribute__((ext_vector_type(4)));
__device__ __forceinline__ void kload8(bf16x8*kf,lds_cptr kp){
  kf[0]=*(const __attribute__((address_space(3))) bf16x8*)(kp);      kf[1]=*(const __attribute__((address_space(3))) bf16x8*)(kp+512);
  kf[2]=*(const __attribute__((address_space(3))) bf16x8*)(kp+2048); kf[3]=*(const __attribute__((address_space(3))) bf16x8*)(kp+2560);
  kf[4]=*(const __attribute__((address_space(3))) bf16x8*)(kp+4096); kf[5]=*(const __attribute__((address_space(3))) bf16x8*)(kp+4608);
  kf[6]=*(const __attribute__((address_space(3))) bf16x8*)(kp+6144); kf[7]=*(const __attribute__((address_space(3))) bf16x8*)(kp+6656);
}
__device__ __forceinline__ void kload2(bf16x8*kf,lds_cptr kp,int j){ kf[2*j]=*(const __attribute__((address_space(3))) bf16x8*)(kp+j*2048); kf[2*j+1]=*(const __attribute__((address_space(3))) bf16x8*)(kp+j*2048+512); }
__device__ __forceinline__ s16x4 vtr(lds_cptr p){ return __builtin_bit_cast(s16x4,__builtin_amdgcn_ds_read_tr16_b64_v4i16((__attribute__((address_space(3))) v4i16_t*)p)); }
__device__ __forceinline__ float rowmax(const f32x16&p0,const f32x16&p1){
  float a=max3f(p0[0],p0[1],p1[0]),b=max3f(p0[2],p0[3],p1[1]);a=max3f(a,p1[2],p1[3]);
  #pragma unroll
  for(int r=4;r<16;r+=4){a=max3f(a,p0[r],p0[r+1]);b=max3f(b,p0[r+2],p0[r+3]);a=max3f(a,p1[r],p1[r+1]);b=max3f(b,p1[r+2],p1[r+3]);}
  const float m=max2f(a,b);
  auto rr=__builtin_amdgcn_permlane32_swap(__float_as_uint(m),__float_as_uint(m),false,false);
  return max2f(__uint_as_float(rr[0]),__uint_as_float(rr[1]));
}
__device__ __forceinline__ void pv(f32x16*o,int vb,bf16x8 pa0,bf16x8 pa1,bf16x8 pa2,bf16x8 pa3){
  #pragma unroll
  for(int d0=0;d0<2;++d0){s16x4 lo[4],hi[4];
    #pragma unroll
    for(int ks=0;ks<4;++ks){
      asm volatile("ds_read_b64_tr_b16 %0,%1 offset:%c2":"=&v"(lo[ks]):"v"(vb),"i"(d0*4096+ks*1024):"memory");
      asm volatile("ds_read_b64_tr_b16 %0,%1 offset:%c2":"=&v"(hi[ks]):"v"(vb),"i"(d0*4096+ks*1024+512):"memory");}
    asm volatile("s_waitcnt lgkmcnt(0)":::"memory");SBAR();
    #define PK(k) (bf16x8){lo[k][0],lo[k][1],lo[k][2],lo[k][3],hi[k][0],hi[k][1],hi[k][2],hi[k][3]}
    o[d0]=__builtin_amdgcn_mfma_f32_32x32x16_bf16(pa0,PK(0),o[d0],0,0,0);
    o[d0]=__builtin_amdgcn_mfma_f32_32x32x16_bf16(pa1,PK(1),o[d0],0,0,0);
    o[d0]=__builtin_amdgcn_mfma_f32_32x32x16_bf16(pa2,PK(2),o[d0],0,0,0);
    o[d0]=__builtin_amdgcn_mfma_f32_32x32x16_bf16(pa3,PK(3),o[d0],0,0,0);
    #undef PK
  }
}

#ifndef ATTN_STORE16
#define ATTN_STORE16(p,v) (*(u32x4*)(p)=(v))
#endif
template<int THRL> __device__ __forceinline__ void attn_unit(int b,int h,int qb,int jt0,const bf16*Q,const bf16*__restrict__ K,const bf16*__restrict__ V,const float*DKbh,const float*ogh,bf16*O,char*shm,const int wid,const bool pref,const int nb,const int nh,const int nqb,const int njt0,const float*DKall){
  const int lane=pg8::pg8_lane_id(),tid=wid*64+lane,r32=lane&31,hi=lane>>5; (void)tid;
  const long rowbase=(long)b*SEQ; const int q0=qb*QB;
  const bf16*Qw=Q+(rowbase+q0+wid*QBLK)*PQ+h*D;
  const bf16*Kh=K+(rowbase+(long)jt0*KVBLK)*PQ+h*D,*Vh=V+(rowbase+(long)jt0*KVBLK)*PQ+h*D; const float*Dh=DKbh+(long)jt0*KVBLK;
  const unsigned lds0=(unsigned)(uintptr_t)shm;
  float*wsf=(float*)(shm+LDS_WS)+wid*64;
  const unsigned koff=(unsigned)(lane*PQ+wid*8)*2u;
  const unsigned voff=(unsigned)((16*(wid&3)+(lane>>2))*PQ+(wid>>2)*32+(lane&3)*8)*2u, doff=(unsigned)lane*4u;
  const unsigned kdst=lds0+LDS_K+wid*1024, vdst=lds0+LDS_V+wid*1024, ddst=lds0+LDS_DK+wid*(NSLOT*256);
  #define DMA_K(t,slot) glds16s(Kh+(long)(t)*KVBLK*PQ,koff,(unsigned)__builtin_amdgcn_readfirstlane(kdst+(slot)))
  #define DMA_V(t,slot) glds16s(Vh+(long)(t)*KVBLK*PQ,voff,(unsigned)__builtin_amdgcn_readfirstlane(vdst+(slot)))
  #define DMA_D(t,slot) glds4s(Dh+(long)(t)*KVBLK,doff,(unsigned)__builtin_amdgcn_readfirstlane(ddst+((slot)>>5)))
  const int vb0=(int)(lds0+LDS_V)+((lane>>4)&1)*32+(lane&3)*8+(4*hi+((lane&15)>>2))*64;
  const char*Kbase=shm+LDS_K; bf16x8 kf[8];
  const lds_cptr shm3=(lds_cptr)shm; const lds_cptr kp0=shm3+LDS_K+hi*1024+r32*16; const lds_cptr vp0=shm3+LDS_V+((lane>>4)&1)*32+(lane&3)*8+(4*hi+((lane&15)>>2))*64;
  const lds_cptr dp0=shm3+LDS_DK+wid*(NSLOT*256)+hi*16;
  const int NT=(q0+QB)/KVBLK-jt0;
  if(!pref){DMA_K(0,0);DMA_D(0,0);DMA_V(0,0);DMA_K(1,SLOTB);}
  bf16x8 qr[4];
  if(!pref){
    #pragma unroll
    for(int d0=0;d0<4;++d0)qr[d0]=*reinterpret_cast<const bf16x8*>(&Qw[(long)r32*PQ+d0*16+hi*8]);
  }
  float mhat=0.f,l_reg=0.f;f32x16 o[2];o[0]=f32x16{};o[1]=f32x16{};const f32x16 zz=f32x16{};
  typedef float f32x4_t __attribute__((ext_vector_type(4)));
  #define BIAS(P0,P1,sl,MH) do{ const lds_cptr dq_=dp0+((sl)>>5); _Pragma("unroll") for(int g_=0;g_<4;++g_){ \
      { const f32x4_t d_=*(const __attribute__((address_space(3))) f32x4_t*)(dq_+32*g_); _Pragma("unroll") for(int j_=0;j_<4;++j_) P0[4*g_+j_]=(P0[4*g_+j_]-(MH))-d_[j_]; } asm volatile("":::"memory"); \
      { const f32x4_t d_=*(const __attribute__((address_space(3))) f32x4_t*)(dq_+32*g_+128); _Pragma("unroll") for(int j_=0;j_<4;++j_) P1[4*g_+j_]=(P1[4*g_+j_]-(MH))-d_[j_]; } asm volatile("":::"memory"); } }while(0)
  const int qrel=wid*QBLK+r32;
  #define CMASK(P0,P1,t) do{int jb_=(t)-(NT-4); if(jb_>=0)cmask(P0,P1,jb_,qrel,hi);}while(0)
  bool resc=false;
  #define START(P0,P1) do{ const float rm=rowmax(P0,P1); resc=false; \
    { const float dl=rm; mhat=fadd_s(mhat,dl); \
      _Pragma("unroll") for(int r=0;r<16;++r){P0[r]=fsub_s(P0[r],dl);P1[r]=fsub_s(P1[r],dl);} } \
    _Pragma("unroll") for(int r=0;r<16;++r)P0[r]=__builtin_amdgcn_exp2f(P0[r]); }while(0)
  #define RESC() do{ if(resc){ asm volatile("s_waitcnt lgkmcnt(0)":::"memory"); \
      _Pragma("unroll") for(int d_=0;d_<2;++d_) _Pragma("unroll") for(int r=0;r<16;++r)o[d_][r]*=wsf[crow(r,hi)]; } }while(0)
  f32x16 pA0,pA1,pB0,pB1;
  int sl_prev=0,sl_cur=0,sl_next=SLOTB;
  #define ROT() do{sl_prev=sl_cur;sl_cur=sl_next;sl_next=(sl_next==(NSLOT-1)*SLOTB)?0:sl_next+SLOTB;}while(0)
  DMA_K(2,2*SLOTB);DMA_D(1,SLOTB);
  WAIT_BAR(4);
  if(pref){
    #pragma unroll
    for(int d0=0;d0<4;++d0)qr[d0]=*(const __attribute__((address_space(3))) bf16x8*)(shm3+LDS_QPF+wid*4096+d0*1024+lane*16);
  }
  qkt(pA0,pA1,Kbase,qr,r32,hi);asm volatile("s_nop 15\n\ts_nop 7":"+v"(pA0),"+v"(pA1));BIAS(pA0,pA1,0,0.f);CMASK(pA0,pA1,0);
  START(pA0,pA1);
  _Pragma("unroll") for(int r=0;r<16;++r)pA1[r]=__builtin_amdgcn_exp2f(pA1[r]);
  WAIT_BAR(0);
  DMA_K(3,0);DMA_V(1,SLOTB);DMA_D(2,2*SLOTB);
  ROT();
  kload8(kf,kp0+sl_cur);
  WAIT_BAR(3);
  s16x4 vlo[8],vhi[8]; u32x4 pw0,pw1,pw2,pw3;
  #define PKW(P,B) cvtpk_s(P[B],P[B+1])
  #define PAF(k) __builtin_bit_cast(bf16x8,pw##k)
  #define VFR(i) (bf16x8){vlo[i][0],vlo[i][1],vlo[i][2],vlo[i][3],vhi[i][0],vhi[i][1],vhi[i][2],vhi[i][3]}
  #define PIN(x) asm volatile("":"+v"(x))
  #define MX3(a,b,c) __builtin_fmaxf(__builtin_fmaxf((a),(b)),(c))
  #define GAPA(MF,A0,A1,A2,A3,W0,W1,PW) do{ MF; sacc+=A0; sacc+=A1; sacc+=A2; sacc+=A3; PIN(sacc); W0; W1; PIN(PW); SBAR(); }while(0)
  #define EX(v) __builtin_amdgcn_exp2f(v)
  #define GAPB(MF,X,B) do{ MF; X[B]=EX(X[B]); X[B+1]=EX(X[B+1]); X[B+2]=EX(X[B+2]); X[B+3]=EX(X[B+3]); PIN(X); SBAR(); }while(0)
  #define VRD(i) do{ vlo[i]=vtr(vp_+(((i)>>2)*4096+((i)&3)*1024)); vhi[i]=vtr(vp_+(((i)>>2)*4096+((i)&3)*1024+512)); }while(0)
  #define KRD(G,j) do{ if(G){ kload2(kf,kp0+sl_next,j); SBAR(); } }while(0)
  #define STEP(C0,C1,P0,P1,t,GK,GV,GL,GD) do{ SBAR(); \
    const lds_cptr vp_=vp0+sl_prev; \
    VRD(0); SBAR(); float sacc=(P0[0]+P0[1]); \
    GAPA(C0=__builtin_amdgcn_mfma_f32_32x32x16_bf16(kf[0],qr[0],zz,0,0,0), P0[2],P0[3],P0[4],P0[5],     pw0[0]=PKW(P0,0), pw0[1]=PKW(P0,2), pw0); \
    VRD(4); SBAR(); GAPA(C1=__builtin_amdgcn_mfma_f32_32x32x16_bf16(kf[1],qr[0],zz,0,0,0), P0[6],P0[7],P0[8],P0[9],     pw0[2]=PKW(P0,4), pw0[3]=PKW(P0,6), pw0); \
    VRD(1); SBAR(); GAPA(C0=__builtin_amdgcn_mfma_f32_32x32x16_bf16(kf[2],qr[1],C0,0,0,0),   P0[10],P0[11],P0[12],P0[13], pw1[0]=PKW(P0,8), pw1[1]=PKW(P0,10), pw1); \
    VRD(5); SBAR(); GAPA(C1=__builtin_amdgcn_mfma_f32_32x32x16_bf16(kf[3],qr[1],C1,0,0,0),   P0[14],P0[15],P1[0],P1[1],   pw1[2]=PKW(P0,12),pw1[3]=PKW(P0,14), pw1); \
    VRD(2); SBAR(); GAPA(C0=__builtin_amdgcn_mfma_f32_32x32x16_bf16(kf[4],qr[2],C0,0,0,0),   P1[2],P1[3],P1[4],P1[5],     pw2[0]=PKW(P1,0), pw2[1]=PKW(P1,2), pw2); \
    VRD(6); SBAR(); GAPA(C1=__builtin_amdgcn_mfma_f32_32x32x16_bf16(kf[5],qr[2],C1,0,0,0),   P1[6],P1[7],P1[8],P1[9],     pw2[2]=PKW(P1,4), pw2[3]=PKW(P1,6), pw2); \
    VRD(3); SBAR(); GAPA(C0=__builtin_amdgcn_mfma_f32_32x32x16_bf16(kf[6],qr[3],C0,0,0,0),   P1[10],P1[11],P1[12],P1[13], pw3[0]=PKW(P1,8), pw3[1]=PKW(P1,10), pw3); \
    VRD(7); SBAR(); GAPA(C1=__builtin_amdgcn_mfma_f32_32x32x16_bf16(kf[7],qr[3],C1,0,0,0),   P1[14],P1[15],0.f,0.f,       pw3[2]=PKW(P1,12),pw3[3]=PKW(P1,14), pw3); \
    l_reg+=sacc; \
    if(GK){DMA_K((t)+3,sl_cur);} if(GV){DMA_V((t)+1,sl_next);} if(GD){DMA_D((t)+2,sl_prev);} \
    BIAS(C0,C1,sl_cur,mhat); \
    CMASK(C0,C1,t); \
    { float a=MX3(C0[0],C0[1],C1[0]),b=MX3(C0[2],C0[3],C1[1]); a=MX3(a,C1[2],C1[3]); \
      _Pragma("unroll") for(int r=4;r<16;r+=4){a=MX3(a,C0[r],C0[r+1]);b=MX3(b,C0[r+2],C0[r+3]);a=MX3(a,C1[r],C1[r+1]);b=MX3(b,C1[r+2],C1[r+3]);} \
      float rm=__builtin_fmaxf(a,b); { auto rr=__builtin_amdgcn_permlane32_swap(__float_as_uint(rm),__float_as_uint(rm),false,false); rm=__builtin_fmaxf(__uint_as_float(rr[0]),__uint_as_float(rr[1])); } \
      resc=false; \
      if(__builtin_expect(__any(rm>(float)THRL),0)){ const float dl=__builtin_fmaxf(rm,0.f); mhat+=dl; \
        _Pragma("unroll") for(int r=0;r<16;++r){C0[r]-=dl;C1[r]-=dl;} \
        const float f=__builtin_amdgcn_exp2f(-dl); l_reg*=f; if(hi==0)wsf[r32]=f; resc=true; } } \
    SBAR(); \
    GAPB(o[0]=__builtin_amdgcn_mfma_f32_32x32x16_bf16(PAF(0),VFR(0),o[0],0,0,0), C0,0); \
    GAPB(o[1]=__builtin_amdgcn_mfma_f32_32x32x16_bf16(PAF(0),VFR(4),o[1],0,0,0), C0,4); \
    KRD(GL,0); GAPB(o[0]=__builtin_amdgcn_mfma_f32_32x32x16_bf16(PAF(1),VFR(1),o[0],0,0,0), C0,8); \
    KRD(GL,1); GAPB(o[1]=__builtin_amdgcn_mfma_f32_32x32x16_bf16(PAF(1),VFR(5),o[1],0,0,0), C0,12); \
    KRD(GL,2); GAPB(o[0]=__builtin_amdgcn_mfma_f32_32x32x16_bf16(PAF(2),VFR(2),o[0],0,0,0), C1,0); \
    KRD(GL,3); GAPB(o[1]=__builtin_amdgcn_mfma_f32_32x32x16_bf16(PAF(2),VFR(6),o[1],0,0,0), C1,4); \
    GAPB(o[0]=__builtin_amdgcn_mfma_f32_32x32x16_bf16(PAF(3),VFR(3),o[0],0,0,0), C1,8); \
    GAPB(o[1]=__builtin_amdgcn_mfma_f32_32x32x16_bf16(PAF(3),VFR(7),o[1],0,0,0), C1,12); \
    }while(0)
  int t=1;
  #undef CMASK
  #define CMASK(P0,P1,t) do{}while(0)
  for(;t+5<NT;t+=2){
    STEP(pB0,pB1,pA0,pA1,t,true,true,true,true);     WAIT_BAR(3); RESC(); ROT();
    STEP(pA0,pA1,pB0,pB1,t+1,true,true,true,true);   WAIT_BAR(3); RESC(); ROT();
  }
  #undef CMASK
  #define CMASK(P0,P1,t) do{int jb_=(t)-(NT-4); if(jb_>=0)cmask(P0,P1,jb_,qrel,hi);}while(0)
  #define ENDW(tt) do{ if((tt)+3<NT){WAIT_BAR(3);} else if((tt)+2<NT){WAIT_BAR(2);} else {WAIT_BAR(0);} }while(0)
  for(;t+1<NT;t+=2){
    STEP(pB0,pB1,pA0,pA1,t,(t+3<NT),(t+1<NT),(t+1<NT),(t+2<NT));       ENDW(t);   RESC(); ROT();
    STEP(pA0,pA1,pB0,pB1,t+1,(t+4<NT),(t+2<NT),(t+2<NT),(t+3<NT));     ENDW(t+1); RESC(); ROT();
  }
  STEP(pB0,pB1,pA0,pA1,NT-1,false,false,false,false); RESC();
  { float sacc=pB0[0]+pB0[1]; _Pragma("unroll") for(int r=2;r<16;++r)sacc+=pB0[r]; _Pragma("unroll") for(int r=0;r<16;++r)sacc+=pB1[r]; l_reg+=sacc;
    pw0=(u32x4){PKW(pB0,0),PKW(pB0,2),PKW(pB0,4),PKW(pB0,6)};pw1=(u32x4){PKW(pB0,8),PKW(pB0,10),PKW(pB0,12),PKW(pB0,14)};pw2=(u32x4){PKW(pB1,0),PKW(pB1,2),PKW(pB1,4),PKW(pB1,6)};pw3=(u32x4){PKW(pB1,8),PKW(pB1,10),PKW(pB1,12),PKW(pB1,14)};
    SBAR(); pv(o,vb0+sl_cur,PAF(0),PAF(1),PAF(2),PAF(3)); }
  float ogv[8];
  #pragma unroll
  for(int e=0;e<8;++e)ogv[e]=ogh[(lane&7)*8+e];
  asm volatile("s_waitcnt lgkmcnt(0)\n\ts_barrier":::"memory");
  if(nqb>=0){ const long nrow=(long)nb*SEQ+(long)njt0*KVBLK; const bf16*nKh=K+nrow*PQ+nh*D,*nVh=V+nrow*PQ+nh*D; const float*nDh=DKall+(long)(nb*NHEAD+nh)*SEQ+(long)njt0*KVBLK;
    glds16s(nKh,koff,(unsigned)__builtin_amdgcn_readfirstlane(kdst)); glds4s(nDh,doff,(unsigned)__builtin_amdgcn_readfirstlane(ddst)); glds16s(nVh,voff,(unsigned)__builtin_amdgcn_readfirstlane(vdst)); glds16s(nKh+(long)KVBLK*PQ,koff,(unsigned)__builtin_amdgcn_readfirstlane(kdst+SLOTB));
    const bf16*nQw=Q+((long)nb*SEQ+(long)nqb*QB+wid*QBLK)*PQ+nh*D; const unsigned qoff=(unsigned)(r32*PQ+hi*8)*2u, qdst=lds0+LDS_QPF+wid*4096;
    #pragma unroll
    for(int d0=0;d0<4;++d0)glds16s(nQw+d0*16,qoff,(unsigned)__builtin_amdgcn_readfirstlane(qdst+d0*1024)); }
  #undef PKW
  #undef PAF
  #undef VFR
  #undef PIN
  #undef MX3
  #undef GAPA
  #undef GAPB
  #undef EX
  #undef VRD
  #undef KRD
  #undef STEP
  #undef ENDW
  {auto rr=__builtin_amdgcn_permlane32_swap(__float_as_uint(l_reg),__float_as_uint(l_reg),false,false);l_reg=__uint_as_float(rr[0])+__uint_as_float(rr[1]);}
  if(hi==0)wsf[32+r32]=l_reg;asm volatile("s_waitcnt lgkmcnt(0)":::"memory");
  float rli[16];
  #pragma unroll
  for(int r=0;r<16;++r)rli[r]=__builtin_amdgcn_rcpf(wsf[32+crow(r,hi)]);
  unsigned char*Ow=(unsigned char*)O+(rowbase+q0+wid*QBLK)*PO+h*D;
  { bf16*stg=(bf16*)(shm+LDS_OST)+wid*2048;
    #pragma unroll
    for(int r=0;r<16;++r){const int orow=crow(r,hi);
      #pragma unroll
      for(int d0=0;d0<2;++d0)stg[orow*64+d0*32+r32]=__float2bfloat16(o[d0][r]*rli[r]);}
    asm volatile("s_waitcnt lgkmcnt(0)":::"memory");
    #pragma unroll
    for(int i=0;i<4;++i){const int row=i*8+(lane>>3),ch=lane&7; const u32x4 v=*(const u32x4*)(stg+row*64+ch*8);
      float x[8]={__builtin_bit_cast(float,v[0]<<16),__builtin_bit_cast(float,v[0]&0xffff0000u),__builtin_bit_cast(float,v[1]<<16),__builtin_bit_cast(float,v[1]&0xffff0000u),
                  __builtin_bit_cast(float,v[2]<<16),__builtin_bit_cast(float,v[2]&0xffff0000u),__builtin_bit_cast(float,v[3]<<16),__builtin_bit_cast(float,v[3]&0xffff0000u)};
      float ss=0.f;
      #pragma unroll
      for(int e=0;e<8;++e)ss+=x[e]*x[e];
      ss+=__shfl_xor(ss,1);ss+=__shfl_xor(ss,2);ss+=__shfl_xor(ss,4);
      const float rn=1.0f/sqrtf(ss*(1.f/64.f)+1e-6f);
      float yv[8];
      #pragma unroll
      for(int e=0;e<8;++e)yv[e]=x[e]*rn*ogv[e];
      typedef unsigned u32x2_t __attribute__((ext_vector_type(2)));
      u32x2_t w; w.x=pg8::pk4_i8y(yv[0],yv[1],yv[2],yv[3]); w.y=pg8::pk4_i8y(yv[4],yv[5],yv[6],yv[7]);
      *(u32x2_t*)(Ow+(long)row*PO+ch*8)=w;} }
  asm volatile("s_waitcnt lgkmcnt(0)":::"memory");
  #undef DMA_K
  #undef DMA_V
  #undef CMASK
  #undef START
  #undef RESC
  #undef ROT
  #undef BIAS
  #undef DMA_D
}
constexpr int ATTN_LDS_BYTES=LDS_BYTES;
struct AttnTensors { const bf16* Q; const bf16* K; const bf16* V; const float* DK; const int* JT0; const float* og; bf16* O; };
struct AttnUnit { int bh; int qb; };
struct StaticOrder {
  int vcu;
  __device__ __forceinline__ explicit StaticOrder(int grid,int block):vcu((block%8)*(grid/8)+block/8){}
  __device__ __forceinline__ bool next(int i,AttnUnit&u)const{ if(i>=4)return false; const int s=vcu&7; u.bh=vcu>>3; u.qb=(i==0)?s:(i==1)?15-s:(i==2)?16+s:31-s; return true; }
  __device__ __forceinline__ void a_ready(const AttnUnit&)const{}
  __device__ __forceinline__ void done(const AttnUnit&)const{}
};
template<class Sched,int THRL=8> __device__ __forceinline__ void attn_phase(char*lds,const AttnTensors&T,const Sched&S,const int wid){
  AttnUnit u,un; bool have=S.next(0,u),pref=false;
  for(int i=0;have;++i){ S.a_ready(u); const bool hn=S.next(i+1,un);
    const int jt0=__builtin_amdgcn_readfirstlane(__hip_atomic_load(T.JT0+u.bh*NQB+u.qb,__ATOMIC_RELAXED,__HIP_MEMORY_SCOPE_AGENT));
    int njt0=0; if(hn)njt0=__builtin_amdgcn_readfirstlane(__hip_atomic_load(T.JT0+un.bh*NQB+un.qb,__ATOMIC_RELAXED,__HIP_MEMORY_SCOPE_AGENT));
    attn_unit<THRL>(u.bh/NHEAD,u.bh%NHEAD,u.qb,jt0,T.Q,T.K,T.V,T.DK+(long)u.bh*SEQ,T.og+(u.bh%NHEAD)*D,T.O,lds,wid,pref,hn?un.bh/NHEAD:0,hn?un.bh%NHEAD:0,hn?un.qb:-1,njt0,T.DK); S.done(u);
    pref=hn; u=un; have=hn; }
}
#undef SBAR
#undef WAIT_BAR
}
struct Args { const float* in[19]; float* out; unsigned char* ws; int ph_lo, ph_hi; };
typedef const __attribute__((address_space(4))) Args* KArgs;
struct Ctx { LAS unsigned char* lds; int tid, lane, wave, vcu, G, gw, NGW; };

__device__ __forceinline__ void tr_item(const float* W, int ldw, int k0, int c0, bf16* WT, int Kp, int r0, LAS float* scr, int lane) {
#pragma unroll
    for (int i = 0; i < 32; ++i) { const int kk = 2 * i + (lane >> 5); scr[kk * 33 + (lane & 31)] = W[(size_t)(k0 + kk) * ldw + c0 + (lane & 31)]; }
    LDS_WAIT(); asm volatile("" ::: "memory");
    const int c = lane & 7;
#pragma unroll
    for (int j = 0; j < 4; ++j) { const int n = (lane >> 3) + 8 * j; const LAS float* s = scr + (8 * c) * 33 + n;
        v4u o; o.x = pk2(s[0 * 33], s[1 * 33]); o.y = pk2(s[2 * 33], s[3 * 33]); o.z = pk2(s[4 * 33], s[5 * 33]); o.w = pk2(s[6 * 33], s[7 * 33]);
        *(GAS v4u*)(WT + (size_t)(r0 + n) * Kp + k0 + 8 * c) = o; }
    LDS_WAIT(); asm volatile("" ::: "memory");
}
__device__ __forceinline__ int gu_row(int f, int up) { return 256 * (f >> 7) + (up ? 128 : 0) + (f & 127); }
__device__ __forceinline__ void conv_finish(const unsigned (&d)[16], unsigned char* rowp, int p) {
    unsigned o[16];
#pragma unroll
    for (int m = 0; m < 8; ++m) {
        const unsigned mine = p ? d[8 + m] : d[m], send = p ? d[m] : d[8 + m];
        const unsigned got = (unsigned)__shfl_xor((int)send, 32);
        const unsigned E = p ? got : mine, O = p ? mine : got;
        o[2 * m] = __builtin_amdgcn_perm(O, E, 0x05010400u); o[2 * m + 1] = __builtin_amdgcn_perm(O, E, 0x07030602u);
    }
#pragma unroll
    for (int j = 0; j < 4; ++j) *(GAS v4u*)(rowp + 16 * j) = (v4u){o[4 * j], o[4 * j + 1], o[4 * j + 2], o[4 * j + 3]};
}
__device__ __forceinline__ void slab_i8(const Ctx& C, const float* W, int ldw, int c0, signed char* WT, int r0, float* sb, LAS float* cm) {
    const int n = C.lane & 31, p = C.lane >> 5;
    const float* src = W + (size_t)(128 * C.wave) * ldw + c0 + (p * ldw + n);
    float v[64];
#pragma unroll
    for (int i = 0; i < 64; ++i) v[i] = src[(size_t)(2 * i) * ldw];
    float mx = 0.f;
#pragma unroll
    for (int i = 0; i < 64; ++i) mx = fmaxf(mx, fabsf(v[i]));
    mx = fmaxf(mx, __shfl_xor(mx, 32));
    if (p == 0) cm[C.wave * 32 + n] = mx;
    __syncthreads();
    float m = cm[n];
#pragma unroll
    for (int w = 1; w < 8; ++w) m = fmaxf(m, cm[w * 32 + n]);
    const float inv = m > 0.f ? 127.f / m : 0.f;
    if (C.wave == 0 && p == 0) sb[r0 + n] = m > 0.f ? m * (1.f / 127.f) : 1.f;
    unsigned d[16];
#pragma unroll
    for (int q = 0; q < 16; ++q) {
        const unsigned t0 = __float_as_uint(fmaf(v[4 * q], inv, 12582912.f)), t1 = __float_as_uint(fmaf(v[4 * q + 1], inv, 12582912.f)), t2 = __float_as_uint(fmaf(v[4 * q + 2], inv, 12582912.f)), t3 = __float_as_uint(fmaf(v[4 * q + 3], inv, 12582912.f));
        d[q] = __builtin_amdgcn_perm(t1, t0, 0x0c0c0400u) | __builtin_amdgcn_perm(t3, t2, 0x04000c0cu); }
    conv_finish(d, (unsigned char*)WT + (size_t)(r0 + n) * DM + 128 * C.wave + 64 * p, p);
}
__device__ __forceinline__ void block_f8(const float* W, int ldw, int k0, int c0, unsigned char* WT, int Kp, int r0, float sc, int lane) {
    const int n = lane & 31, p = lane >> 5;
    const float* src = W + (size_t)k0 * ldw + c0 + (p * ldw + n);
    float v[64];
#pragma unroll
    for (int i = 0; i < 64; ++i) v[i] = src[(size_t)(2 * i) * ldw];
    unsigned d[16];
#pragma unroll
    for (int q = 0; q < 16; ++q) d[q] = pg8::pk4_fp8(v[4 * q] * sc, v[4 * q + 1] * sc, v[4 * q + 2] * sc, v[4 * q + 3] * sc);
    conv_finish(d, WT + (size_t)(r0 + n) * Kp + k0 + 64 * p, p);
}
struct F8Blk { const float* W; unsigned char* WT; int k0, c0; };
__device__ __forceinline__ void block_f8_x2(const F8Blk a, const F8Blk b, float sc, int lane) {
    const int n = lane & 31, p = lane >> 5;
    const float* sa_ = a.W + (size_t)a.k0 * DM + a.c0 + (p * DM + n); const float* sb_ = b.W + (size_t)b.k0 * DM + b.c0 + (p * DM + n);
    float va[64], vb[64];
#pragma unroll
    for (int i = 0; i < 64; ++i) va[i] = sa_[(size_t)(2 * i) * DM];
#pragma unroll
    for (int i = 0; i < 64; ++i) vb[i] = sb_[(size_t)(2 * i) * DM];
    unsigned d[16];
#pragma unroll
    for (int q = 0; q < 16; ++q) d[q] = pg8::pk4_fp8(va[4 * q] * sc, va[4 * q + 1] * sc, va[4 * q + 2] * sc, va[4 * q + 3] * sc);
    conv_finish(d, a.WT + (size_t)(a.c0 + n) * FF + a.k0 + 64 * p, p);
#pragma unroll
    for (int q = 0; q < 16; ++q) d[q] = pg8::pk4_fp8(vb[4 * q] * sc, vb[4 * q + 1] * sc, vb[4 * q + 2] * sc, vb[4 * q + 3] * sc);
    conv_finish(d, b.WT + (size_t)(b.c0 + n) * FF + b.k0 + 64 * p, p);
}
constexpr int PI_IN0 = 0, PI_OUT = 104, PI_FGU = 232, PI_FD = 456, PI_IN1 = 568, PI_MOE = 672, PI_END = 672 + 8 * 336;
__device__ __forceinline__ void prep_item(const Ctx& C, KArgs ka, unsigned char* ws, int it, int& par) {
    LAS float* cm = (LAS float*)(C.lds + 126976) + (par & 1) * 256;
    if (it < PI_OUT || (it >= PI_IN1 && it < PI_MOE)) { const int l = it >= PI_IN1, nb = it - (l ? PI_IN1 : PI_IN0), n0 = 32 * nb;
        const int c0 = n0 < 1024 ? ((n0 & ~255) + 64 * ((n0 >> 5) & 3) + 32 * ((n0 >> 7) & 1)) : (n0 < 1536 ? n0 : n0 + 8);
        slab_i8(C, ka->in[2] + (size_t)l * DM * DIN, DIN, c0, (signed char*)(ws + W_IN + l * W_IN_STRIDE), n0, (float*)(ws + T_SBIN) + l * NZ, cm); ++par; }
    else if (it < PI_FGU) { const int r = it - PI_OUT, l = r >> 5, nb = r & 31;
        if (r < 64) { slab_i8(C, ka->in[9] + (size_t)l * DM * DM, DM, 32 * nb, (signed char*)(ws + W_OUT + l * W_OUT_STRIDE), 32 * nb, (float*)(ws + T_SBO) + l * DM, cm); ++par; } }
    else if (it < PI_FD) { const int r = it - PI_FGU, up = r / 112, nb = r % 112;
        slab_i8(C, up ? ka->in[12] : ka->in[11], FF, 32 * nb, (signed char*)(ws + W_FGU), gu_row(32 * nb, up), (float*)(ws + T_SBF), cm); ++par; }
    else if (it < PI_IN1) { const int t8 = (it - PI_FD) * 8 + C.wave, kb = t8 >> 5, nb = t8 & 31;
        block_f8(ka->in[13], DM, 128 * kb, 32 * nb, ws + W_FD, FF, 32 * nb, S_WDN, C.lane); }
    else { const int r0 = it - PI_MOE, e = r0 / 336, r = r0 % 336;
        if (r < 224) { const int up = r / 112, nb = r % 112;
            slab_i8(C, (up ? ka->in[17] : ka->in[16]) + (size_t)e * DM * FF, FF, 32 * nb, (signed char*)(ws + W_MGU + e * W_MGU_STRIDE), gu_row(32 * nb, up), (float*)(ws + T_SBM) + e * 7168, cm); ++par; }
        else { const int t8 = (r - 224) * 8 + C.wave, kb = t8 >> 5, nb = t8 & 31;
            block_f8(ka->in[18] + (size_t)e * FF * DM, DM, 128 * kb, 32 * nb, ws + W_MD + e * W_MD_STRIDE, FF, 32 * nb, S_WDN, C.lane); } }
}
__device__ __forceinline__ int moe_slab_item(int s) { return PI_MOE + (s / 224) * 336 + s % 224; }
__device__ __forceinline__ int moe_down_item(int d) { return PI_MOE + (d / 112) * 336 + 224 + d % 112; }
__device__ __forceinline__ void moe_down_block(KArgs ka, unsigned char* ws, int B, int lane) { const int e = B / 896, t8 = B % 896, kb = t8 >> 5, nb = t8 & 31;
    block_f8(ka->in[18] + (size_t)e * FF * DM, DM, 128 * kb, 32 * nb, ws + W_MD + e * W_MD_STRIDE, FF, 32 * nb, S_WDN, lane); }
__device__ __forceinline__ void prep_lb(const Ctx& C, KArgs ka, unsigned char* ws) {
    if (C.vcu == 0 && C.tid < 256) { const float a = ka->in[7][C.tid], b = ka->in[7][256 + C.tid]; const float mx = fmaxf(a, b), ea = __expf(a - mx), eb = __expf(b - mx);
        float* lb = (float*)(ws + T_LB); lb[C.tid] = 0.f; lb[256 + C.tid] = eb / (ea + eb); }
}

__device__ __forceinline__ float reduce8_cols(const float (&a)[8], int lane) {
    const bool b0 = lane & 1, b1 = lane & 2, b2 = lane & 4;
    float n[4], m2[2];
#pragma unroll
    for (int i = 0; i < 4; ++i) { const float keep = b0 ? a[2 * i + 1] : a[2 * i], send = b0 ? a[2 * i] : a[2 * i + 1]; n[i] = keep + DPPF(send, 0xB1, 0xF); }
#pragma unroll
    for (int i = 0; i < 2; ++i) { const float keep = b1 ? n[2 * i + 1] : n[2 * i], send = b1 ? n[2 * i] : n[2 * i + 1]; m2[i] = keep + DPPF(send, 0x4E, 0xF); }
    const float keep = b2 ? m2[1] : m2[0], send = b2 ? m2[0] : m2[1];
    float r = keep + __builtin_bit_cast(float, __builtin_amdgcn_ds_swizzle(__builtin_bit_cast(int, send), 0x101f));
    r += DPPF(r, 0x128, 0xF);
    r += __builtin_bit_cast(float, __builtin_amdgcn_ds_swizzle(__builtin_bit_cast(int, r), 0x401f));
    r += __shfl_xor(r, 32);
    return r;
}
template <int MODE, bool I8OUT = false, bool BFIN = false>
__device__ __forceinline__ void norm_phase(const Ctx& C, const void* xin_, const float* gain, bf16* XN, float* sa, const float* wsrc, int wld, int wc0, const float* bias, float* lsig, int* tope, float* topw, int* rcnt = nullptr) {
    LAS float* wl = (LAS float*)C.lds;
    if (MODE != 1) {
        for (int i = C.tid; i < 8 * 1024; i += NWAVES * 64) { const int k = i >> 3, c = i & 7; wl[c * 1024 + k] = wsrc[(size_t)k * wld + wc0 + c]; }
        __syncthreads();
    }
    f32x4 g[4];
#pragma unroll
    for (int j = 0; j < 4; ++j) g[j] = *(const f32x4*)(gain + 4 * C.lane + 256 * j);
    float bias8 = 0.f; if (MODE != 1) bias8 = bias[C.lane & 7];
    typedef typename std::conditional<BFIN, v2u, f32x4>::type raw_t; constexpr size_t ESZ = BFIN ? 2 : 4;
    const unsigned char* xin = (const unsigned char*)xin_;
    constexpr int NB = 1;
    raw_t nv[NB][4];
#pragma unroll
    for (int r = 0; r < NB; ++r) { const int mr = C.gw + r * C.NGW < M ? C.gw + r * C.NGW : C.gw; const GAS raw_t* xr = (const GAS raw_t*)(xin + (size_t)mr * DM * ESZ) + C.lane;
#pragma unroll
      for (int j = 0; j < 4; ++j) nv[r][j] = xr[64 * j]; }
    for (int mb = C.gw; mb < M; mb += NB * C.NGW) {
      raw_t cur[NB][4];
#pragma unroll
      for (int r = 0; r < NB; ++r)
#pragma unroll
        for (int j = 0; j < 4; ++j) cur[r][j] = nv[r][j];
#pragma unroll
      for (int r = 0; r < NB; ++r) { const int mn = mb + (NB + r) * C.NGW; const GAS raw_t* xr = (const GAS raw_t*)(xin + (size_t)(mn < M ? mn : mb) * DM * ESZ) + C.lane;
#pragma unroll
        for (int j = 0; j < 4; ++j) nv[r][j] = xr[64 * j]; }
#pragma unroll
      for (int r = 0; r < NB; ++r) { const int m = mb + r * C.NGW; if (m >= M) break;
        f32x4 v[4]; f32x4 s4 = {0.f, 0.f, 0.f, 0.f};
#pragma unroll
        for (int j = 0; j < 4; ++j) { if constexpr (BFIN) { const v2u q = __builtin_bit_cast(v2u, cur[r][j]); v[j] = (f32x4){bflo(q.x), bfhi(q.x), bflo(q.y), bfhi(q.y)}; } else v[j] = __builtin_bit_cast(f32x4, cur[r][j]); }
#pragma unroll
        for (int j = 0; j < 4; ++j) s4 = __builtin_elementwise_fma(v[j], v[j], s4);
        const float rstd = 1.0f / sqrtf(wave_sum((s4.x + s4.y) + (s4.z + s4.w)) * (1.f / DM) + EPS);
#pragma unroll
        for (int j = 0; j < 4; ++j) v[j] = I8OUT ? v[j] * g[j] : v[j] * rstd * g[j];
        if (I8OUT) {
            float mx = 0.f;
#pragma unroll
            for (int j = 0; j < 4; ++j) mx = fmaxf(fmaxf(mx, fmaxf(fabsf(v[j].x), fabsf(v[j].y))), fmaxf(fabsf(v[j].z), fabsf(v[j].w)));
            mx = wave_max_nonneg(mx);
            const float iv = mx > 0.f ? 127.f / mx : 0.f;
            if (C.lane == 0) sa[m] = mx > 0.f ? mx * rstd * (1.f / 127.f) : 1.f;
            GAS unsigned* o4 = (GAS unsigned*)((unsigned char*)XN + (size_t)m * DM) + C.lane;
#pragma unroll
            for (int j = 0; j < 4; ++j) { const unsigned t0 = __float_as_uint(fmaf(v[j].x, iv, 12582912.f)), t1 = __float_as_uint(fmaf(v[j].y, iv, 12582912.f)), t2 = __float_as_uint(fmaf(v[j].z, iv, 12582912.f)), t3 = __float_as_uint(fmaf(v[j].w, iv, 12582912.f));
                o4[64 * j] = __builtin_amdgcn_perm(t1, t0, 0x0c0c0400u) | __builtin_amdgcn_perm(t3, t2, 0x04000c0cu); }
        } else { GAS v2u* o8 = (GAS v2u*)(XN + (size_t)m * DM) + C.lane;
#pragma unroll
            for (int j = 0; j < 4; ++j) { v2u w; w.x = pk2(v[j].x, v[j].y); w.y = pk2(v[j].z, v[j].w); o8[64 * j] = w; } }
        if (MODE != 1) {
            float a8[8];
#pragma unroll
            for (int c = 0; c < 8; ++c) { f32x4 a4 = {0.f, 0.f, 0.f, 0.f};
#pragma unroll
                for (int j = 0; j < 4; ++j) { const f32x4 w = *(const LAS f32x4*)(wl + c * 1024 + 4 * C.lane + 256 * j); a4 = __builtin_elementwise_fma(v[j], w, a4); }
                a8[c] = (a4.x + a4.y) + (a4.z + a4.w); }
            const float tot = reduce8_cols(a8, C.lane) * (I8OUT ? rstd : 1.0f);
            if (MODE == 0) {
                const float mine = tot + bias8;
                const float ls = fminf(mine, 0.f) - log1pf(__expf(-fabsf(mine)));
                if (C.lane < 8) lsig[(size_t)m * 8 + C.lane] = ls;
            } else {
                float acc[8]; { const float tb = tot + bias8;
#pragma unroll
                  for (int c = 0; c < 8; ++c) acc[c] = __builtin_bit_cast(float, __builtin_amdgcn_readlane(__builtin_bit_cast(int, tb), c)); }
                int i0 = 0; float v0 = acc[0];
#pragma unroll
                for (int c = 1; c < 8; ++c) if (acc[c] > v0) { v0 = acc[c]; i0 = c; }
                int i1 = -1; float v1 = -3.0e38f;
#pragma unroll
                for (int c = 0; c < 8; ++c) if (c != i0 && acc[c] > v1) { v1 = acc[c]; i1 = c; }
                const float e = __expf(v1 - v0), w0 = 1.0f / (1.0f + e), w1 = e * w0;
                if (C.lane == 0) { tope[2 * m] = i0; tope[2 * m + 1] = i1; topw[2 * m] = w0; topw[2 * m + 1] = w1;
                    __hip_atomic_fetch_add(rcnt + (m >> 6) * 16 + i0, 1, __ATOMIC_RELAXED, __HIP_MEMORY_SCOPE_AGENT); __hip_atomic_fetch_add(rcnt + (m >> 6) * 16 + 8 + i1, 1, __ATOMIC_RELAXED, __HIP_MEMORY_SCOPE_AGENT); }
            }
        }
      }
    }
}

__device__ __forceinline__ void cumsum_unit(const float* lsig, float* dk2, int* jt0tab, const float* gq, const float* gk, LAS float* sh, int bh, int tid) {
    const int b = bh >> 3, h = bh & 7, lane = tid & 63, wave = tid >> 6; const size_t base = ((size_t)b * SEQ + 16 * tid) * 8 + h;
    float x[16], s = 0.f;
#pragma unroll
    for (int i = 0; i < 16; ++i) { x[i] = lsig[base + (size_t)i * 8]; s += x[i]; }
    float inc = s;
#pragma unroll
    for (int o = 1; o < 64; o <<= 1) { const float t = __shfl_up(inc, o); if (lane >= o) inc += t; }
    if (lane == 63) sh[wave] = inc;
    __syncthreads();
    float run = inc - s;
    for (int w = 0; w < wave; ++w) run += sh[w];
    float* dst = dk2 + (size_t)bh * SEQ + 16 * tid;
#pragma unroll
    for (int i = 0; i < 16; ++i) { run += x[i]; x[i] = run; }
#pragma unroll
    for (int i = 0; i < 4; ++i) *(f32x4*)(dst + 4 * i) = (f32x4){x[4 * i], x[4 * i + 1], x[4 * i + 2], x[4 * i + 3]} * 1.4426950408889634f;
    if ((tid & 15) == 0) sh[16 + (tid >> 4)] = x[0];
    { float s16 = 0.f;
#pragma unroll
      for (int i = 0; i < 16; ++i) s16 += __expf(x[15] - x[i]);
      float tl = -x[15] + __logf(s16);
#pragma unroll
      for (int o = 1; o < 4; o <<= 1) { const float t2 = __shfl_xor(tl, o); tl = fmaxf(tl, t2) + __logf(1.0f + __expf(-fabsf(tl - t2))); }
      if ((tid & 3) == 3) sh[64 + (tid >> 2)] = tl; }
    float gqm = fabsf(gq[lane]), gkm = fabsf(gk[lane]);
#pragma unroll
    for (int o = 1; o < 64; o <<= 1) { gqm = fmaxf(gqm, __shfl_xor(gqm, o)); gkm = fmaxf(gkm, __shfl_xor(gkm, o)); }
    const float TH = 16.0f * gqm * gkm + 9.1f;
    __syncthreads();
    if (tid < 64) { const float a0 = sh[64 + 2 * tid], a1 = sh[64 + 2 * tid + 1];
        const float p1 = fmaxf(a0, a1) + __logf(1.0f + __expf(-fabsf(a0 - a1)));
        float inc = p1;
#pragma unroll
        for (int o = 1; o < 64; o <<= 1) { const float t = __shfl_up(inc, o); if (lane >= o) inc = fmaxf(inc, t) + __logf(1.0f + __expf(-fabsf(inc - t))); }
        const float ex = __shfl_up(inc, 1);
        sh[192 + 2 * tid] = lane == 0 ? a0 : fmaxf(ex, a0) + __logf(1.0f + __expf(-fabsf(ex - a0)));
        sh[192 + 2 * tid + 1] = inc; }
    __syncthreads();
    if (tid < 32) { const int qb = tid; const float Di0 = sh[16 + qb]; int lo = 0, hi = 4 * qb;
        const float Pq = qb > 0 ? sh[192 + 4 * qb - 1] : -Di0, mref = fmaxf(Pq, -Di0);
        while (lo < hi) { const int mid = (lo + hi) >> 1; const float A = sh[192 + mid];
            const float kept = mref + __logf(fmaxf(__expf(Pq - mref) - __expf(A - mref), 0.f) + __expf(-Di0 - mref));
            if (A - kept >= -TH) hi = mid; else lo = mid + 1; }
        jt0tab[bh * 32 + qb] = lo & ~1; }
}

__device__ __forceinline__ float sum8_dpp(float v) {
    v += __builtin_bit_cast(float, __builtin_amdgcn_update_dpp(0, __builtin_bit_cast(int, v), 0xB1, 0xF, 0xF, false));
    v += __builtin_bit_cast(float, __builtin_amdgcn_update_dpp(0, __builtin_bit_cast(int, v), 0x4E, 0xF, 0xF, false));
    v += __builtin_bit_cast(float, __builtin_amdgcn_update_dpp(0, __builtin_bit_cast(int, v), 0x141, 0xF, 0xF, false));
    return v; }
__device__ __forceinline__ float wave_scan_incl(float x) {
    x += DPPF(x, 0x111, 0xF); x += DPPF(x, 0x112, 0xF); x += DPPF(x, 0x114, 0xF); x += DPPF(x, 0x118, 0xF);
    x += DPPF(x, 0x142, 0xA); x += DPPF(x, 0x143, 0xC); return x; }
__device__ __forceinline__ float lane_read(float x, int l) { return __builtin_bit_cast(float, __builtin_amdgcn_readlane(__builtin_bit_cast(int, x), l)); }
__device__ __forceinline__ void hgrn_h1(const Ctx& C, const bf16* HG, const float* lbl, bf16* U, float* dch) {
    typedef short bf16x8_t __attribute__((ext_vector_type(8))); typedef float f32x16_t __attribute__((ext_vector_type(16)));
    LAS unsigned short* VTb = (LAS unsigned short*)(C.lds + 16384); LAS unsigned short* KTb = (LAS unsigned short*)(C.lds + 25600); LAS float* SC = (LAS float*)(C.lds + 34816); LAS float* LB = (LAS float*)(C.lds + 36864); constexpr int HP = 72;
    __syncthreads();
    if (C.tid < 256) LB[C.tid] = lbl[C.tid];
    const int t = C.lane, c8 = 8 * C.wave;
    v4u nf = {0u, 0u, 0u, 0u}, ni = nf;
    if (C.vcu < 2048) { const int u = C.vcu, bh = u >> 7, n = u & 127; const bf16* zp = HG + ((((size_t)((bh >> 2) * 128 + n) * 16 + (bh & 3)) * 8 + C.wave) * 64 + t) * 8; nf = *(const v4u*)(zp + 1 * 16384); ni = *(const v4u*)(zp + 2 * 16384); }
    for (int u = C.vcu; u < 2048; u += C.G) {
        const int bh = u >> 7, h = bh & 3;
        __syncthreads();
        const v4u fw = nf, iw = ni;
        if (u + C.G < 2048) { const int u2 = u + C.G, bh2 = u2 >> 7, n2 = u2 & 127; const bf16* zp = HG + ((((size_t)((bh2 >> 2) * 128 + n2) * 16 + (bh2 & 3)) * 8 + C.wave) * 64 + t) * 8; nf = *(const v4u*)(zp + 1 * 16384); ni = *(const v4u*)(zp + 2 * 16384); }
        float key[8], c[8], cr[8];
        { const f32x4 l0 = *(const LAS f32x4*)(LB + h * 64 + c8), l1 = *(const LAS f32x4*)(LB + h * 64 + c8 + 4); const float lbv[8] = {l0.x, l0.y, l0.z, l0.w, l1.x, l1.y, l1.z, l1.w};
          const float zf[8] = {bflo(fw.x), bfhi(fw.x), bflo(fw.y), bfhi(fw.y), bflo(fw.z), bfhi(fw.z), bflo(fw.w), bfhi(fw.w)};
          const unsigned short vraw[8] = {(unsigned short)(iw.x & 0xffffu), (unsigned short)(iw.x >> 16), (unsigned short)(iw.y & 0xffffu), (unsigned short)(iw.y >> 16), (unsigned short)(iw.z & 0xffffu), (unsigned short)(iw.z >> 16), (unsigned short)(iw.w & 0xffffu), (unsigned short)(iw.w >> 16)};
#pragma unroll
          for (int e = 0; e < 8; ++e) { const float lb = lbv[e]; const float f = lb + (1.0f - lb) * __builtin_amdgcn_rcpf(1.0f + __expf(-zf[e])); key[e] = 1.0f - f; c[e] = __logf(fmaxf(f, 1e-30f)); VTb[(c8 + e) * HP + t] = vraw[e]; } }
#pragma unroll
        for (int e = 0; e < 8; ++e) c[e] = wave_scan_incl(c[e]);
        float c63[8];
#pragma unroll
        for (int e = 0; e < 8; ++e) { cr[e] = lane_read(c[e], 31); c63[e] = lane_read(c[e], 63); }
#pragma unroll
        for (int e = 0; e < 8; ++e) KTb[(c8 + e) * HP + t] = (unsigned short)f2bf(key[e] * __expf(fminf(fmaxf(cr[e] - c[e], -80.f), 80.f)));
        if (t == 0) { float sc[8], dc[8];
#pragma unroll
            for (int e = 0; e < 8; ++e) { sc[e] = __expf(fmaxf(c63[e] - cr[e], -80.f)); dc[e] = __expf(c63[e]); }
            *(LAS f32x4*)(SC + c8) = (f32x4){sc[0], sc[1], sc[2], sc[3]}; *(LAS f32x4*)(SC + c8 + 4) = (f32x4){sc[4], sc[5], sc[6], sc[7]};
            *(f32x4*)(dch + u * 64 + c8) = (f32x4){dc[0], dc[1], dc[2], dc[3]}; *(f32x4*)(dch + u * 64 + c8 + 4) = (f32x4){dc[4], dc[5], dc[6], dc[7]}; }
        __syncthreads();
        if (C.wave < 4) { const int vb = C.wave >> 1, kb = C.wave & 1, r32 = C.lane & 31, hi = C.lane >> 5;
            f32x16_t acc = {};
#pragma unroll
            for (int ks = 0; ks < 4; ++ks) { const bf16x8_t a = *(const LAS bf16x8_t*)(VTb + (32 * vb + r32) * HP + 16 * ks + 8 * hi), bb = *(const LAS bf16x8_t*)(KTb + (32 * kb + r32) * HP + 16 * ks + 8 * hi);
                acc = __builtin_amdgcn_mfma_f32_32x32x16_bf16(a, bb, acc, 0, 0, 0); }
            const int k = 32 * kb + r32; const float sc = SC[k];
            LAS unsigned short* stg = (LAS unsigned short*)(C.lds + 40960 + C.wave * 2560);
#pragma unroll
            for (int r = 0; r < 16; ++r) { const int vl = (r & 3) + 8 * (r >> 2) + 4 * hi; stg[vl * 40 + r32] = (unsigned short)f2bf(acc[r] * sc); }
            LDS_WAIT(); asm volatile("" ::: "memory");
#pragma unroll
            for (int j = 0; j < 2; ++j) { const int pi = C.lane + 64 * j, row = pi >> 2, q = pi & 3;
                const v4u w = *(const LAS v4u*)(stg + row * 40 + q * 8);
                *(v4u*)(U + (size_t)u * 4096 + (32 * vb + row) * 64 + 32 * kb + q * 8) = w; }
            LDS_WAIT(); asm volatile("" ::: "memory");
        }
    }
    __syncthreads();
}
__device__ __forceinline__ void hgrn_h2(const Ctx& C, bf16* U, const float* dch) {
    const int gid = C.vcu * 256 + C.tid;
    if (C.tid < 256 && gid < 16 * 4096) { const int bh = gid >> 12, vk = gid & 4095, k = vk & 63; float s = 0.f;
#pragma unroll 32
        for (int n = 0; n < 128; ++n) { const size_t idx = (size_t)bh * 128 + n; const float uu = bf2f(U[idx * 4096 + vk]), d = dch[idx * 64 + k]; U[idx * 4096 + vk] = (bf16)f2bf(s); s = d * s + uu; } }
}
__device__ __forceinline__ void hgrn_h3(const Ctx& C, const bf16* HG, const float* lbl, const bf16* U, const float* og, bf16* Y) {
    typedef short bf16x8_t __attribute__((ext_vector_type(8))); typedef short bf16x4_t __attribute__((ext_vector_type(4))); typedef float f32x16_t __attribute__((ext_vector_type(16)));
    constexpr int HP = 72, OP = 68, SETB = 36864;
    LAS float* OT = (LAS float*)(C.lds + 73728); LAS float* LB = (LAS float*)(C.lds + 91136); LAS float* OG = (LAS float*)(C.lds + 92160);
    __syncthreads();
    if (C.tid < 256) { LB[C.tid] = lbl[C.tid]; OG[C.tid] = og[768 + C.tid]; }
    const int nu = C.vcu < 2048 ? (2048 - C.vcu + C.G - 1) / C.G : 0;
    __syncthreads();
    if (C.wave >= 4) {
        const int pw = C.wave - 4, t = C.lane, c16 = 16 * pw;
        v4u nf[2], ni[2], nq[2], ns[2];
#define H3_LOAD(u_) do { const int bh_ = (u_) >> 7, n_ = (u_) & 127; const bf16* zr_ = HG + (((size_t)((bh_ >> 2) * 128 + n_) * 16 + (bh_ & 3)) * 8) * 512; \
        _Pragma("unroll") for (int w_ = 0; w_ < 2; ++w_) { const bf16* zp_ = zr_ + ((2 * pw + w_) * 64 + t) * 8; nq[w_] = *(const v4u*)(zp_); nf[w_] = *(const v4u*)(zp_ + 16384); ni[w_] = *(const v4u*)(zp_ + 32768); \
            ns[w_] = *(const v4u*)(U + (size_t)(u_) * 4096 + t * 64 + c16 + 8 * w_); } } while (0)
        if (nu > 0) H3_LOAD(C.vcu);
        for (int i = 0; i <= nu; ++i) {
            const int u = C.vcu + i * C.G, h = (u >> 7) & 3;
            LAS unsigned short* VTb = (LAS unsigned short*)(C.lds + (i & 1) * SETB); LAS unsigned short* QB = VTb + 64 * HP; LAS unsigned short* KB = QB + 64 * HP; LAS unsigned short* SB = KB + 64 * HP;
            float key[16], qs[16], c[16]; v4u sw[2];
            if (i < nu) {
                const v4u fw[2] = {nf[0], nf[1]}, iw[2] = {ni[0], ni[1]}, qw[2] = {nq[0], nq[1]}; sw[0] = ns[0]; sw[1] = ns[1];
                if (i + 1 < nu) H3_LOAD(u + C.G);
#pragma unroll
                for (int w = 0; w < 2; ++w) {
                    const f32x4 l0 = *(const LAS f32x4*)(LB + h * 64 + c16 + 8 * w), l1 = *(const LAS f32x4*)(LB + h * 64 + c16 + 8 * w + 4); const float lbv[8] = {l0.x, l0.y, l0.z, l0.w, l1.x, l1.y, l1.z, l1.w};
                    const float zf[8] = {bflo(fw[w].x), bfhi(fw[w].x), bflo(fw[w].y), bfhi(fw[w].y), bflo(fw[w].z), bfhi(fw[w].z), bflo(fw[w].w), bfhi(fw[w].w)};
                    const float qf[8] = {bflo(qw[w].x), bfhi(qw[w].x), bflo(qw[w].y), bfhi(qw[w].y), bflo(qw[w].z), bfhi(qw[w].z), bflo(qw[w].w), bfhi(qw[w].w)};
                    const unsigned short vraw[8] = {(unsigned short)(iw[w].x & 0xffffu), (unsigned short)(iw[w].x >> 16), (unsigned short)(iw[w].y & 0xffffu), (unsigned short)(iw[w].y >> 16), (unsigned short)(iw[w].z & 0xffffu), (unsigned short)(iw[w].z >> 16), (unsigned short)(iw[w].w & 0xffffu), (unsigned short)(iw[w].w >> 16)};
#pragma unroll
                    for (int e = 0; e < 8; ++e) { const float lb = lbv[e]; const float f = lb + (1.0f - lb) * __builtin_amdgcn_rcpf(1.0f + __expf(-zf[e])); key[8 * w + e] = 1.0f - f; c[8 * w + e] = __logf(fmaxf(f, 1e-30f));
                        qs[8 * w + e] = qf[e] * __builtin_amdgcn_rcpf(1.0f + __expf(-qf[e])); VTb[(c16 + 8 * w + e) * HP + t] = vraw[e]; } }
            }
            __syncthreads();
            if (i < nu) {
#pragma unroll
                for (int e = 0; e < 16; ++e) c[e] = wave_scan_incl(c[e]);
#pragma unroll
                for (int w = 0; w < 2; ++w) {
                    const float sv[8] = {bflo(sw[w].x), bfhi(sw[w].x), bflo(sw[w].y), bfhi(sw[w].y), bflo(sw[w].z), bfhi(sw[w].z), bflo(sw[w].w), bfhi(sw[w].w)};
                    float qt[8], kt[8], sp[8];
#pragma unroll
                    for (int e = 0; e < 8; ++e) { const float cr = lane_read(c[8 * w + e], 31); const float d = fminf(fmaxf(c[8 * w + e] - cr, -80.f), 80.f); qt[e] = qs[8 * w + e] * __expf(d); kt[e] = key[8 * w + e] * __expf(-d); sp[e] = sv[e] * __expf(cr); }
                    v4u x; x.x = pk2(qt[0], qt[1]); x.y = pk2(qt[2], qt[3]); x.z = pk2(qt[4], qt[5]); x.w = pk2(qt[6], qt[7]); *(LAS v4u*)(QB + t * HP + c16 + 8 * w) = x;
                    x.x = pk2(kt[0], kt[1]); x.y = pk2(kt[2], kt[3]); x.z = pk2(kt[4], kt[5]); x.w = pk2(kt[6], kt[7]); *(LAS v4u*)(KB + t * HP + c16 + 8 * w) = x;
                    x.x = pk2(sp[0], sp[1]); x.y = pk2(sp[2], sp[3]); x.z = pk2(sp[4], sp[5]); x.w = pk2(sp[6], sp[7]); *(LAS v4u*)(SB + t * HP + c16 + 8 * w) = x; }
            }
            __syncthreads();
        }
#undef H3_LOAD
    } else {
        const int te = C.tid >> 2, c16e = (C.tid & 3) * 16;
        v4u ng[2] = {{0u, 0u, 0u, 0u}, {0u, 0u, 0u, 0u}};
#define H3_LOADG(u_) do { const int bh_ = (u_) >> 7, n_ = (u_) & 127; const bf16* zg_ = HG + (((size_t)((bh_ >> 2) * 128 + n_) * 16 + (bh_ & 3)) * 8) * 512 + 3 * 16384; \
        ng[0] = *(const v4u*)(zg_ + ((2 * (C.tid & 3)) * 64 + te) * 8); ng[1] = *(const v4u*)(zg_ + ((2 * (C.tid & 3) + 1) * 64 + te) * 8); } while (0)
        if (nu > 0) H3_LOADG(C.vcu);
        for (int i = 0; i <= nu; ++i) {
            const int u = C.vcu + (i - 1) * C.G, bh = u >> 7, n = u & 127, b = bh >> 2, h = bh & 3;
            const v4u gw[2] = {ng[0], ng[1]};
            if (i >= 1 && i < nu) H3_LOADG(u + C.G);
            if (i >= 1) {
                const LAS unsigned short* VTb = (const LAS unsigned short*)(C.lds + ((i - 1) & 1) * SETB); const LAS unsigned short* QB = VTb + 64 * HP; const LAS unsigned short* KB = QB + 64 * HP; const LAS unsigned short* SB = KB + 64 * HP;
            { const int vb = C.wave >> 1, tb = C.wave & 1, r32 = C.lane & 31, hi = C.lane >> 5;
            f32x16_t o = {};
            bf16x8_t qf4[4];
#pragma unroll
            for (int ks = 0; ks < 4; ++ks) qf4[ks] = *(const LAS bf16x8_t*)(QB + (32 * tb + r32) * HP + 16 * ks + 8 * hi);
#pragma unroll
            for (int ks = 0; ks < 4; ++ks) { const bf16x8_t a = *(const LAS bf16x8_t*)(SB + (32 * vb + r32) * HP + 16 * ks + 8 * hi); o = __builtin_amdgcn_mfma_f32_32x32x16_bf16(a, qf4[ks], o, 0, 0, 0); }
            for (int sb = 0; sb <= tb; ++sb) {
                f32x16_t x = {};
#pragma unroll
                for (int ks = 0; ks < 4; ++ks) { const bf16x8_t a = *(const LAS bf16x8_t*)(KB + (32 * sb + r32) * HP + 16 * ks + 8 * hi); x = __builtin_amdgcn_mfma_f32_32x32x16_bf16(a, qf4[ks], x, 0, 0, 0); }
                if (sb == tb) {
#pragma unroll
                    for (int r = 0; r < 16; ++r) { const int srow = (r & 3) + 8 * (r >> 2) + 4 * hi; if (srow > r32) x[r] = 0.f; } }
#pragma unroll
                for (int s2 = 0; s2 < 2; ++s2) {
                    v4u pw; pw.x = pk2(x[8 * s2 + 0], x[8 * s2 + 1]); pw.y = pk2(x[8 * s2 + 2], x[8 * s2 + 3]); pw.z = pk2(x[8 * s2 + 4], x[8 * s2 + 5]); pw.w = pk2(x[8 * s2 + 6], x[8 * s2 + 7]);
                    const int s0 = 32 * sb + 16 * s2 + 4 * hi;
                    const bf16x4_t v0 = *(const LAS bf16x4_t*)(VTb + (32 * vb + r32) * HP + s0), v1 = *(const LAS bf16x4_t*)(VTb + (32 * vb + r32) * HP + s0 + 8);
                    const bf16x8_t av = {v0[0], v0[1], v0[2], v0[3], v1[0], v1[1], v1[2], v1[3]};
                    o = __builtin_amdgcn_mfma_f32_32x32x16_bf16(av, __builtin_bit_cast(bf16x8_t, pw), o, 0, 0, 0); }
            }
            LAS float* op = OT + (32 * tb + r32) * OP + 32 * vb + 4 * hi;
#pragma unroll
            for (int g4 = 0; g4 < 4; ++g4) *(LAS f32x4*)(op + 8 * g4) = (f32x4){o[4 * g4 + 0], o[4 * g4 + 1], o[4 * g4 + 2], o[4 * g4 + 3]};
        }
            }
            __syncthreads();
            if (i >= 1) {
                float ov[16], ss = 0.f;
#pragma unroll
                for (int q = 0; q < 4; ++q) { const f32x4 o4 = *(const LAS f32x4*)(OT + te * OP + c16e + 4 * q); ov[4 * q] = o4.x; ov[4 * q + 1] = o4.y; ov[4 * q + 2] = o4.z; ov[4 * q + 3] = o4.w; ss += (o4.x * o4.x + o4.y * o4.y) + (o4.z * o4.z + o4.w * o4.w); }
                ss += DPPF(ss, 0xB1, 0xF); ss += DPPF(ss, 0x4E, 0xF);
                const float r = 1.0f / sqrtf(ss * (1.f / 64.f) + EPS);
                const size_t m = (size_t)b * SEQ + n * 64 + te;
                unsigned yq[4];
#pragma unroll
                for (int w = 0; w < 2; ++w) {
                    const float gf[8] = {bflo(gw[w].x), bfhi(gw[w].x), bflo(gw[w].y), bfhi(gw[w].y), bflo(gw[w].z), bfhi(gw[w].z), bflo(gw[w].w), bfhi(gw[w].w)};
                    const f32x4 g0 = *(const LAS f32x4*)(OG + h * 64 + c16e + 8 * w), g1 = *(const LAS f32x4*)(OG + h * 64 + c16e + 8 * w + 4); const float gg[8] = {g0.x, g0.y, g0.z, g0.w, g1.x, g1.y, g1.z, g1.w};
                    float y[8];
#pragma unroll
                    for (int e = 0; e < 8; ++e) y[e] = ov[8 * w + e] * r * gg[e] * (gf[e] * __builtin_amdgcn_rcpf(1.0f + __expf(-gf[e])));
                    yq[2 * w] = pg8::pk4_i8y(y[0], y[1], y[2], y[3]); yq[2 * w + 1] = pg8::pk4_i8y(y[4], y[5], y[6], y[7]); }
                *(v4u*)((unsigned char*)Y + m * DM + 768 + h * 64 + c16e) = (v4u){yq[0], yq[1], yq[2], yq[3]};
            }
            __syncthreads();
        }
#undef H3_LOADG
    }
    __syncthreads();
}
__device__ __forceinline__ void conv_phase(const Ctx& C, const bf16* Z, const float* cw, const float* og, bf16* Y) {
    const int c0 = 4 * C.lane;
    const f32x4 w0 = *(const f32x4*)(cw + c0), w1 = *(const f32x4*)(cw + 256 + c0), w2 = *(const f32x4*)(cw + 512 + c0), gg = *(const f32x4*)(og + 512 + c0);
    for (int m0 = C.gw * 16; m0 < M; m0 += C.NGW * 16) {
        const int t0 = m0 & (SEQ - 1);
        v2u rx[16], rc[16], rb[16], hx[2], hc[2];
#pragma unroll
        for (int i = 0; i < 2; ++i) { const bf16* zp = Z + (size_t)(t0 >= 2 - i ? m0 - 2 + i : m0) * ZP + c0; hx[i] = *(const v2u*)(zp + ZCX); hc[i] = *(const v2u*)(zp + ZCC); }
#pragma unroll
        for (int i = 0; i < 16; ++i) { const bf16* zp = Z + (size_t)(m0 + i) * ZP + c0; rx[i] = *(const v2u*)(zp + ZCX); rc[i] = *(const v2u*)(zp + ZCC); rb[i] = *(const v2u*)(zp + ZCB); }
        f32x4 u2 = {0.f, 0.f, 0.f, 0.f}, u1 = u2;
        if (t0 >= 2) u2 = (f32x4){bflo(hx[0].x) * bflo(hc[0].x), bfhi(hx[0].x) * bfhi(hc[0].x), bflo(hx[0].y) * bflo(hc[0].y), bfhi(hx[0].y) * bfhi(hc[0].y)};
        if (t0 >= 1) u1 = (f32x4){bflo(hx[1].x) * bflo(hc[1].x), bfhi(hx[1].x) * bfhi(hc[1].x), bflo(hx[1].y) * bflo(hc[1].y), bfhi(hx[1].y) * bfhi(hc[1].y)};
#pragma unroll
        for (int i = 0; i < 16; ++i) { const int m = m0 + i;
            const v2u xv = rx[i], cv = rc[i], bv = rb[i];
            const f32x4 u0 = {bflo(xv.x) * bflo(cv.x), bfhi(xv.x) * bfhi(cv.x), bflo(xv.y) * bflo(cv.y), bfhi(xv.y) * bfhi(cv.y)};
            const f32x4 acc = u2 * w0 + u1 * w1 + u0 * w2;
            f32x4 y = {bflo(bv.x) * acc.x, bfhi(bv.x) * acc.y, bflo(bv.y) * acc.z, bfhi(bv.y) * acc.w};
            float ss = (y.x * y.x + y.y * y.y) + (y.z * y.z + y.w * y.w);
            ss += DPPF(ss, 0xB1, 0xF); ss += DPPF(ss, 0x4E, 0xF); ss += DPPF(ss, 0x141, 0xF); ss += DPPF(ss, 0x140, 0xF);
            const float r = 1.0f / sqrtf(ss * (1.f / 64.f) + EPS);
            y = y * r * gg;
            *(unsigned*)((unsigned char*)Y + (size_t)m * DM + 512 + c0) = pg8::pk4_i8y(y.x, y.y, y.z, y.w);
            u2 = u1; u1 = u0; }
    }
}

__device__ __forceinline__ void moe_count(const Ctx& C, unsigned char* ws) {
    int* idx = (int*)(ws + T_IDX);
    for (int i = C.vcu * (NWAVES * 64) + C.tid; i < MAXROWS; i += C.G * NWAVES * 64) idx[i] = -1;
}
__device__ __forceinline__ int moe_remap(int lin, int P0, int m0, int m1) { if (lin < P0) return lin < m0 ? lin : m0 + m1 + (lin - m0); const int pl = lin - P0; return pl < m1 ? m0 + pl : m0 + m1 + (P0 - m0) + (pl - m1); }
__device__ __forceinline__ void moe_scan(const Ctx& C, unsigned char* ws) {
    if (C.vcu != 0) return;
    LAS int* cl = (LAS int*)C.lds;
    LAS int* sh = cl + 512 * 16;
    const int* cnt = (const int*)(ws + WS_CTL + CNT_CTL_OFF); int* cbase = (int*)(ws + T_CBASE); int* pexp = (int*)(ws + T_PEXP); int* meta = (int*)(ws + T_META);
    typedef int i32x4 __attribute__((ext_vector_type(4)));
#pragma unroll
    for (int j = 0; j < 4; ++j) *(LAS i32x4*)(cl + C.tid * 16 + 4 * j) = (i32x4){ldi(cnt + C.tid * 16 + 4 * j), ldi(cnt + C.tid * 16 + 4 * j + 1), ldi(cnt + C.tid * 16 + 4 * j + 2), ldi(cnt + C.tid * 16 + 4 * j + 3)};
    __syncthreads();
#pragma unroll
    for (int cc = 0; cc < 2; ++cc) { const int c = 2 * C.wave + cc; int v[8], s = 0;
#pragma unroll
        for (int i = 0; i < 8; ++i) { v[i] = cl[(8 * C.lane + i) * 16 + c]; s += v[i]; }
        int inc = s;
#pragma unroll
        for (int o = 1; o < 64; o <<= 1) { const int t = __shfl_up(inc, o); if (C.lane >= o) inc += t; }
        int run = inc - s;
#pragma unroll
        for (int i = 0; i < 8; ++i) { cl[(8 * C.lane + i) * 16 + c] = run; run += v[i]; }
        if (C.lane == 63) sh[c] = inc; }
    __syncthreads();
    if (C.tid == 0) { int pos = 0, P0 = 0;
        for (int r = 0; r < 2; ++r) { for (int e = 0; e < 8; ++e) { sh[16 + r * 8 + e] = pos; pos += ((sh[r * 8 + e] + 255) / 256) * 256; } if (r == 0) P0 = pos / 256; }
        sh[32] = P0; sh[33] = pos / 256; sh[34] = 0; sh[35] = 0; }
    __syncthreads();
    { const int P0 = sh[32], P = sh[33], P1 = P - P0, m0 = P0 < 128 ? P0 : 128, m1 = P1 < 128 ? P1 : 128;
      if (C.tid < P) { const int lin = C.tid; int i = 0;
#pragma unroll
          for (int j = 1; j < 16; ++j) if (lin >= (sh[16 + j] >> 8)) i = j;
          pexp[moe_remap(lin, P0, m0, m1)] = i & 7;
          if (lin < P0) { if (lin >= m0) atomicOr((unsigned*)(sh + 34), 1u << (i & 7)); } else if (lin - P0 >= m1) atomicOr((unsigned*)(sh + 35), 1u << (i & 7)); }
      __syncthreads();
      if (C.tid == 0) { const int emask0 = sh[34], emask1 = sh[35], eu = emask0 | emask1;
        meta[0] = 0; meta[1] = P0; meta[2] = P; meta[3] = m0; meta[4] = m1; meta[5] = (emask0 == 0 || emask1 == 0 || (eu & (eu - 1)) == 0) ? 1 : 0; } }
    __syncthreads();
#pragma unroll
    for (int j = 0; j < 4; ++j) { i32x4 o = *(const LAS i32x4*)(cl + C.tid * 16 + 4 * j); const i32x4 st = *(const LAS i32x4*)(sh + 16 + 4 * j); o += st; *(i32x4*)(cbase + C.tid * 16 + 4 * j) = o; }
}
__device__ __forceinline__ void moe_assign(const Ctx& C, unsigned char* ws) {
    const int* tope = (const int*)(ws + T_TOPE); const float* topw = (const float*)(ws + T_TOPW); const int* cbase = (const int*)(ws + T_CBASE); const int* meta = (const int*)(ws + T_META);
    int* idx = (int*)(ws + T_IDX); float* wgt = (float*)(ws + T_WGT);
    const int P0 = ldi(meta + 1), m0 = ldi(meta + 3), m1 = ldi(meta + 4), mg = ldi(meta + 5);
    const unsigned long long below = (1ull << C.lane) - 1ull;
    for (int ck = C.gw; ck < M / 64; ck += C.NGW) {
        const int tok = ck * 64 + C.lane; int pl[2];
        const int cbv = ldi(cbase + ck * 16 + (C.lane & 15));
#pragma unroll
        for (int r = 0; r < 2; ++r) { const int er = ldi(tope + 2 * tok + r); int before = 0;
#pragma unroll
            for (int e = 0; e < 8; ++e) { const unsigned long long mk = __ballot(er == e); if (er == e) before = __popcll(mk & below); }
            pl[r] = __shfl(cbv, r * 8 + er) + before; }
        const int ph0 = (pl[0] >> 8) < m0 ? 23 : 22, ph1 = ((pl[1] >> 8) - P0) < m1 ? 25 : (mg ? 22 : 24);
#pragma unroll
        for (int r = 0; r < 2; ++r) { const int pos = moe_remap(pl[r] >> 8, P0, m0, m1) * 256 + (pl[r] & 255); const int first = r == 0 ? (ph0 < ph1) : (ph1 < ph0);
            idx[pos] = tok | (first << 30); wgt[pos] = topw[2 * tok + r]; }
    }
}
__device__ __forceinline__ void moe_gather(const Ctx& C, unsigned char* ws, int np) {
    const int* idx = (const int*)(ws + T_IDX); const unsigned char* XN2 = ws + WS_B; unsigned char* XS = ws + WS_XS; const float* sa = (const float*)(ws + T_SA); float* sas = (float*)(ws + T_SAS);
    const int nrows = np * 256; constexpr int RT = 8;
    int tok[RT];
#pragma unroll
    for (int i = 0; i < RT; ++i) tok[i] = (C.gw * RT + i < nrows) ? ldi(idx + C.gw * RT + i) : -1;
    for (int r0 = C.gw * RT; r0 < nrows; r0 += C.NGW * RT) {
        v4u a[RT]; float s[RT]; int tn[RT];
#pragma unroll
        for (int i = 0; i < RT; ++i) { a[i] = (v4u){0u, 0u, 0u, 0u}; s[i] = 0.f; if (tok[i] >= 0) { const int tk = tok[i] & 0x3fffffff; a[i] = ((const v4u*)(XN2 + (size_t)tk * DM))[C.lane]; s[i] = sa[tk]; } }
#pragma unroll
        for (int i = 0; i < RT; ++i) { const int rn = r0 + C.NGW * RT + i; tn[i] = rn < nrows ? ldi(idx + rn) : -1; }
#pragma unroll
        for (int i = 0; i < RT; ++i) if (r0 + i < nrows) { ((v4u*)(XS + (size_t)(r0 + i) * DM))[C.lane] = a[i]; if (C.lane == 0) sas[r0 + i] = s[i]; }
#pragma unroll
        for (int i = 0; i < RT; ++i) tok[i] = tn[i];
    }
}

#ifndef MK_MULTI
#define MK_MULTI 0
#endif
constexpr int NPH = 26;
#define IN(k) (lo <= (k) && (k) < hi)
#define FRESH() KArgs ka = ka0; asm volatile("" : "+s"(ka)); unsigned char* ws = ka->ws; float* out = ka->out; Ctx C; C.lds = C0.lds; C.G = C0.G; C.NGW = C0.NGW; { int w_ = C0.wave; asm volatile("" : "+s"(w_)); C.wave = w_; C.lane = pg8::pg8_lane_id(); C.tid = w_ * 64 + C.lane; int v_ = C0.vcu; asm volatile("" : "+s"(v_)); C.vcu = v_; C.gw = v_ * NWAVES + C.wave; } bf16* WA = (bf16*)(ws + WS_A); bf16* WB = (bf16*)(ws + WS_B); bf16* Z = (bf16*)(ws + WS_S); bf16* XB = (bf16*)(ws + WS_XB); (void)XB; float* lsig = (float*)(ws + T_LSIG); float* dcum = (float*)(ws + T_DCUM); (void)WA; (void)WB; (void)Z; (void)lsig; (void)dcum; (void)out
#define SEAM(k) do { if (lo <= (k) && (k) + 1 < hi) xcd_barrier(bar); } while (0)

template <int l> __device__ __forceinline__ void layer_common(const KArgs ka0, const Ctx& C0, const XcdBarrier& bar, const int lo, const int hi) {
        const int pb = 9 * l;
        if (IN(1 + pb)) {
            if (l == 0) { FRESH(); int par = 0; const int lim = C.G == 256 ? PI_FGU : PI_MOE;
                for (int it = (int)blockIdx.x; it < lim; it += C.G) prep_item(C, ka, ws, it, par); prep_lb(C, ka, ws); __syncthreads(); }
            { FRESH(); if constexpr (l == 0) norm_phase<0, true, false>(C, ka->in[0], ka->in[1] + l * DM, WA, (float*)(ws + T_SA), ka->in[2] + (size_t)l * DM * DIN, DIN, 1536, ka->in[3] + l * 8, lsig, nullptr, nullptr);
              else norm_phase<0, true, true>(C, XB, ka->in[1] + l * DM, WA, (float*)(ws + T_SA), ka->in[2] + (size_t)l * DM * DIN, DIN, 1536, ka->in[3] + l * 8, lsig, nullptr, nullptr); } }
        SEAM(1 + pb);
        if (IN(2 + pb)) { FRESH();
            pg8::Gemm g{WA, (const bf16*)(ws + W_IN + l * W_IN_STRIDE), M, NZ, DM / 2}; pg8::StaticOrder S; S.init(M, NZ, C.G, (int)blockIdx.x);
            typedef pg8::EpiStoreI8<(long)((WS_HG - WS_S) / 2)> EpiIn; EpiIn E{Z, ZP, (const float*)(ws + T_SA), (const float*)(ws + T_SBIN) + l * NZ, ka->in[4] + l * 64, ka->in[5] + l * 64};
            pg8::gemm_phase<EpiIn, pg8::StaticOrder, true, true, true>(C.lds + RING_OFF, g, S, E, C.wave);
            { const int bx = (int)blockIdx.x; if (bx >= 128 && bx < 160) cumsum_unit(lsig, (float*)(ws + T_DK2), (int*)(ws + T_JT0), ka->in[4] + l * 64, ka->in[5] + l * 64, (LAS float*)C.lds, bx - 128, C.tid); }
            if (l == 0) { const int j = (int)blockIdx.x - 128;
                if (j >= 0 && C.G == 256) { FRESH(); int par = 0; for (int r = 0; r < 2; ++r) { const int q = r * 128 + j; prep_item(C, ka, ws, q < 224 ? PI_FGU + q : PI_IN1 + q - 224, par); }
                    if (j < 72) prep_item(C, ka, ws, PI_IN1 + 32 + j, par); else prep_item(C, ka, ws, moe_slab_item(j - 72), par); } }
            else { const int j = (int)blockIdx.x - 128;
                if (j >= 0 && C.G == 256) { FRESH(); int par = 0; const int n = j < 32 ? 3 : 4, s0 = j < 32 ? 56 + 3 * j : 152 + 4 * (j - 32); for (int r = 0; r < n; ++r) prep_item(C, ka, ws, moe_slab_item(s0 + r), par); } }
        }
        SEAM(2 + pb);
        if (IN(3 + pb)) { FRESH();
            { conv_phase(C, Z, ka->in[6] + l * 768, ka->in[8] + l * DM, WA); }
            { FRESH(); hgrn_h1(C, (const bf16*)(ws + WS_HG), (const float*)(ws + T_LB) + l * 256, (bf16*)(ws + WS_B), (float*)(ws + WS_B + 32 * MiB)); } }
        SEAM(3 + pb);
        if (IN(4 + pb)) { FRESH(); hgrn_h2(C, (bf16*)(ws + WS_B), (const float*)(ws + WS_B + 32 * MiB));
            if (C.wave >= 4 && C.G == 256) { F8Blk bl[2];
#pragma unroll
                for (int jj = 0; jj < 2; ++jj) { const int s = jj * 1024 + C.vcu * 4 + (C.wave - 4);
                    if (l == 0 && s < 896) bl[jj] = F8Blk{ka->in[13], ws + W_FD, 128 * (s >> 5), 32 * (s & 31)};
                    else { const int B = l == 0 ? s - 896 : 1152 + s, e = B / 896, t8 = B % 896; bl[jj] = F8Blk{ka->in[18] + (size_t)e * FF * DM, ws + W_MD + e * W_MD_STRIDE, 128 * (t8 >> 5), 32 * (t8 & 31)}; } }
                block_f8_x2(bl[0], bl[1], S_WDN, C.lane); } }
        SEAM(4 + pb);
        if (IN(5 + pb)) { FRESH();
            { hgrn_h3(C, (const bf16*)(ws + WS_HG), (const float*)(ws + T_LB) + l * 256, (const bf16*)(ws + WS_B), ka->in[8] + l * DM, WA); }
            { FRESH(); __syncthreads();
              const attn_body::AttnTensors AT{(const attn_body::bf16*)(Z + ZQ), (const attn_body::bf16*)(Z + ZK), (const attn_body::bf16*)(Z + ZV), (const float*)(ws + T_DK2), (const int*)(ws + T_JT0), ka->in[8] + l * DM, (attn_body::bf16*)WA};
              const attn_body::StaticOrder S((int)C.G, (int)blockIdx.x);
              attn_body::attn_phase<attn_body::StaticOrder, 20>((char*)C.lds + RING_OFF, AT, S, C.wave); }
        }
        SEAM(5 + pb);
        if (IN(6 + pb)) { FRESH();
            pg8::Gemm g{WA, (const bf16*)(ws + W_OUT + l * W_OUT_STRIDE), M, DM, DM / 2}; pg8::StaticOrder S; S.init(M, DM, C.G, (int)blockIdx.x);
            if constexpr (l == 0) { pg8::EpiResidI8<false> E{ka->in[0], (pg8::bf16_t*)XB, DM, 1.0f / pg8::S_Y, (const float*)(ws + T_SBO) + l * DM}; pg8::gemm_phase<pg8::EpiResidI8<false>, pg8::StaticOrder, true, true, true>(C.lds + RING_OFF, g, S, E, C.wave); }
            else { pg8::EpiResidI8<true> E{XB, (pg8::bf16_t*)XB, DM, 1.0f / pg8::S_Y, (const float*)(ws + T_SBO) + l * DM}; pg8::gemm_phase<pg8::EpiResidI8<true>, pg8::StaticOrder, true, true, true>(C.lds + RING_OFF, g, S, E, C.wave); }
        }
        SEAM(6 + pb);
        if (IN(7 + pb)) { FRESH();
            if (l == 0) norm_phase<1, true, true>(C, XB, ka->in[10] + l * DM, WB, (float*)(ws + T_SA), nullptr, 0, 0, nullptr, nullptr, nullptr, nullptr);
            else norm_phase<2, true, true>(C, XB, ka->in[10] + l * DM, WB, (float*)(ws + T_SA), ka->in[14], 8, 0, ka->in[15], nullptr, (int*)(ws + T_TOPE), (float*)(ws + T_TOPW), (int*)(ws + WS_CTL + CNT_CTL_OFF));
        }
        if (l == 0) SEAM(7 + pb);
}
__device__ __forceinline__ void ffn_dense(const KArgs ka0, const Ctx& C0, const XcdBarrier& bar, const int lo, const int hi) {
            if (IN(8)) { FRESH();
                pg8::Gemm g{(const bf16*)(ws + WS_B), (const bf16*)(ws + W_FGU), M, 2 * FF, DM / 2}; pg8::StaticOrder S; S.init(M, 2 * FF, C.G, (int)blockIdx.x);
                pg8::EpiSwiGLUi8 E{ws + WS_HD, FF, (const float*)(ws + T_SA), (const float*)(ws + T_SBF), 0, S_HID};
                pg8::gemm_phase<pg8::EpiSwiGLUi8, pg8::StaticOrder, true, true, true>(C.lds + RING_OFF, g, S, E, C.wave);
            }
            SEAM(8);
            if (IN(9)) { FRESH();
                pg8::Gemm g{(const bf16*)(ws + WS_HD), (const bf16*)(ws + W_FD), M, DM, FF / 2}; pg8::StaticOrder S; S.init(M, DM, C.G, (int)blockIdx.x);
                pg8::EpiResidB<true, true> E{XB, (pg8::bf16_t*)XB, DM, 1.0f / (S_HID * S_WDN), (const float*)(ws + T_SA)};
                pg8::gemm_phase<pg8::EpiResidB<true, true>, pg8::StaticOrder, true, true, false, true>(C.lds + RING_OFF, g, S, E, C.wave);
            }
            SEAM(9);
}
__device__ __forceinline__ void ffn_moe(const KArgs ka0, const Ctx& C0, const XcdBarrier& bar, const int lo, const int hi) {
            if (IN(17)) { FRESH(); int par = 0; __syncthreads();
                if (C.G == 256) { for (int x = (int)blockIdx.x; x < 1001 + 496; x += C.G) prep_item(C, ka, ws, x < 1001 ? moe_slab_item(791 + x) : moe_down_item(400 + x - 1001), par); }
                else { for (int it = PI_MOE + (int)blockIdx.x; it < PI_END; it += C.G) prep_item(C, ka, ws, it, par); }
                moe_count(C, ws); } SEAM(17);
            if (IN(18)) { FRESH(); moe_scan(C, ws); if (C.vcu != 0 && C.G == 256) { FRESH(); int par = 0; prep_item(C, ka, ws, moe_slab_item(536 + C.vcu - 1), par); } } SEAM(18);
            if (IN(19)) { FRESH(); moe_assign(C, ws); } SEAM(19);
            if (IN(20)) { FRESH(); const int npall = __builtin_amdgcn_readfirstlane(ldi((const int*)(ws + T_META) + 2)); moe_gather(C, ws, npall); }
            SEAM(20);
            int m0 = 0, m1 = 0, t0 = 0, t1 = 0, mg = 1;
            if (hi > 21 && lo < 26) { FRESH(); const int* meta = (const int*)(ws + T_META);
                const int P0 = __builtin_amdgcn_readfirstlane(ldi(meta + 1)), P = __builtin_amdgcn_readfirstlane(ldi(meta + 2));
                m0 = __builtin_amdgcn_readfirstlane(ldi(meta + 3)); m1 = __builtin_amdgcn_readfirstlane(ldi(meta + 4)); mg = __builtin_amdgcn_readfirstlane(ldi(meta + 5)); t0 = P0 - m0; t1 = (P - P0) - m1; }
            const int tdA = mg ? t0 + t1 : t0, tdB = mg ? 0 : t1;
            const int nlA = (4 * tdA + 7) & ~7, nlB = (4 * tdB + 7) & ~7;
            for (int it = 0; it < 5; ++it) {
                    const int ph = 21 + it;
                    const int dp0 = it == 1 ? m0 + m1 : (it == 2 ? 0 : (it == 3 ? m0 + m1 + t0 : m0)), dnp = it == 0 ? 0 : (it == 1 ? tdA : (it == 2 ? m0 : (it == 3 ? tdB : m1)));
                    const int dlate = it == 1 ? nlA : (it == 3 ? nlB : 0);
                    const size_t dh = (it == 1 || it == 3) ? WS_HT + (it == 3 ? (size_t)t0 * 256 * FF : 0) : WS_HM;
                    const int up0 = it == 0 ? m0 + m1 : (it == 1 ? 0 : m0), unp = it == 0 ? t0 + t1 : (it == 1 ? m0 : (it == 3 ? m1 : 0));
                    const int ulate = it == 1 ? nlA : (it == 3 ? nlB : 0);
                    const size_t uh = it == 0 ? WS_HT : WS_HM;
                    if (IN(ph) && dnp > 0) { FRESH();
                        pg8::Gemm g{(const bf16*)(ws + dh), (const bf16*)(ws + W_MD), dnp * 256, DM, FF / 2};
                        pg8::MoeOrder S; if (dlate) S.base.init(dnp * 256, DM, dlate, (int)blockIdx.x - (C.G - dlate)); else S.base.init(dnp * 256, DM, C.G, (int)blockIdx.x);
                        S.pexp = (const int*)(ws + T_PEXP) + dp0; S.estride = (long)W_MD_STRIDE; S.nlate = 0; S.nA = 0;
                        typedef pg8::EpiMoeDown<(int)offsetof(Args, out), (int)offsetof(Args, ws), WS_XB, T_WGT - T_IDX, T_SAS - T_IDX, DM> EpiMD; EpiMD E{(const int*)(ws + T_IDX) + dp0 * 256, 1.0f / (S_HID * S_WDN)};
                        pg8::gemm_phase<EpiMD, pg8::MoeOrder, true, true, false, true>(C.lds + RING_OFF, g, S, E, C.wave);
                    }
                    if (IN(ph) && unp > 0) { FRESH();
                        pg8::Gemm g{(const bf16*)(ws + WS_XS + (size_t)up0 * 256 * DM), (const bf16*)(ws + W_MGU), unp * 256, 2 * FF, DM / 2};
                        pg8::MoeOrder S; S.base.init(unp * 256, 2 * FF, C.G, (int)blockIdx.x); S.pexp = (const int*)(ws + T_PEXP) + up0; S.estride = (long)W_MGU_STRIDE; S.nlate = ulate; S.nA = 3;
                        pg8::EpiSwiGLUi8 E{ws + uh, FF, (const float*)(ws + T_SAS) + up0 * 256, (const float*)(ws + T_SBM), 7168, S_HID};
                        pg8::gemm_phase<pg8::EpiSwiGLUi8, pg8::MoeOrder, true, true, true>(C.lds + RING_OFF, g, S, E, C.wave);
                    }
                    SEAM(ph);
                }
}
__global__ void __launch_bounds__(NWAVES * 64, 2) fwd(Args args) {
    extern __shared__ __attribute__((aligned(16))) unsigned char lds[];
    Ctx C0;
    C0.lds = (LAS unsigned char*)lds;
    C0.tid = 0; C0.lane = 0; C0.wave = __builtin_amdgcn_readfirstlane((int)threadIdx.x >> 6);
    C0.G = gridDim.x; { const int bx = blockIdx.x; C0.vcu = (C0.G % 8 == 0) ? (bx % 8) * (C0.G / 8) + bx / 8 : bx; }
    C0.gw = C0.vcu * NWAVES + C0.wave; C0.NGW = C0.G * NWAVES;
    const KArgs ka0 = (KArgs)__builtin_amdgcn_kernarg_segment_ptr();
    volatile LAS unsigned* MISC = (volatile LAS unsigned*)(C0.lds + MISC_OFF);
    for (int u = threadIdx.x; u < (LDS_BYTES - LDSCTL_OFF) / 4; u += NWAVES * 64) ((LAS unsigned*)(C0.lds + LDSCTL_OFF))[u] = 0u;
    __syncthreads();
    XcdBarrier bar; bar.bar = (unsigned*)(ka0->ws + WS_CTL) + CW_BAR; bar.x = 0; bar.st = nullptr;
    if (!MK_MULTI) bar = xcd_barrier_post((unsigned*)(ka0->ws + WS_CTL) + CW_BAR, MISC + 8);
    const int lo = ka0->ph_lo, hi = ka0->ph_hi;
    layer_common<0>(ka0, C0, bar, lo, hi);
    ffn_dense(ka0, C0, bar, lo, hi);
    layer_common<1>(ka0, C0, bar, lo, hi);
    ffn_moe(ka0, C0, bar, lo, hi);
}
#undef IN
#undef SEAM

extern "C" void kernel_launch(void* const* d_in, const int* in_sizes, int n_in, void* d_out, int out_size, void* d_ws, size_t ws_size, hipStream_t stream) {
    static int grid = 0;
    if (grid == 0) {
        if (n_in != 19 || in_sizes[0] != M * DM || out_size != M * DM || ws_size < WS_END) { fprintf(stderr, "kernel_launch: unexpected shapes (n_in %d, in0 %d, out %d, ws %zu)\n", n_in, n_in > 0 ? in_sizes[0] : -1, out_size, ws_size); grid = -1; return; }
        int dev = 0, cus = 0, per_cu = 0;
        if (hipGetDevice(&dev) != hipSuccess || hipDeviceGetAttribute(&cus, hipDeviceAttributeMultiprocessorCount, dev) != hipSuccess) { grid = -1; return; }
        if (hipFuncSetAttribute((const void*)fwd, hipFuncAttributeMaxDynamicSharedMemorySize, LDS_BYTES) != hipSuccess) { fprintf(stderr, "kernel_launch: hipFuncSetAttribute failed\n"); grid = -1; return; }
        if (hipOccupancyMaxActiveBlocksPerMultiprocessor(&per_cu, (const void*)fwd, NWAVES * 64, LDS_BYTES) != hipSuccess || per_cu < 1) fprintf(stderr, "kernel_launch: occupancy query reports %d\n", per_cu);
        (void)hipGetLastError();
        grid = cus;
    }
    if (grid < 0) return;
    if (hipMemsetAsync((char*)d_ws + WS_CTL, 0, CTL_ZERO_BYTES, stream) != hipSuccess) return;
    Args a{};
    for (int i = 0; i < 19; ++i) a.in[i] = (const float*)d_in[i];
    a.out = (float*)d_out; a.ws = (unsigned char*)d_ws;
#if MK_MULTI
    for (int p = 0; p < NPH; ++p) { a.ph_lo = p; a.ph_hi = p + 1; hipLaunchKernelGGL(fwd, dim3(grid), dim3(NWAVES * 64), LDS_BYTES, stream, a); }
#else
    a.ph_lo = 0; a.ph_hi = NPH;
    hipLaunchKernelGGL(fwd, dim3(grid), dim3(NWAVES * 64), LDS_BYTES, stream, a);
#endif
}
```
